# Optimizing an MI355X kernel written in HIP

```python
import math
import jax, jax.numpy as jnp
from jax import lax
import numpy as np

D_MODEL = 2048
BATCH = 4
SEQ = 4096
DEPTH = 2

MEM_LEN = 256
NORM_EPS = 1e-6

DA_HEADS = 8
DA_QK_DIM = 64
DA_V_DIM = 2 * DA_QK_DIM
DA_WIDTH = DA_HEADS * DA_V_DIM
Q_BLOCK = 128

HG_HEADS = 8
HG_DK = 128
HG_DV = 128
HG_WIDTH = HG_HEADS * HG_DV
HG_CHUNK = 64

MIX_WIDTH = DA_WIDTH + HG_WIDTH

DA_Q_COLS = DA_HEADS * 2 * DA_QK_DIM
DA_K_COLS = DA_HEADS * 2 * DA_QK_DIM
DA_V_COLS = DA_WIDTH
HG_KEY_COLS = HG_HEADS * HG_DK
HG_VAL_COLS = HG_HEADS * HG_DV
IN_SIZES = (DA_Q_COLS, DA_K_COLS, DA_V_COLS, HG_KEY_COLS, HG_KEY_COLS, HG_VAL_COLS, HG_VAL_COLS)
IN_COLS = sum(IN_SIZES)
IN_SPLITS = tuple(int(v) for v in np.cumsum(IN_SIZES)[:-1])

REL_BUCKETS = 32
REL_MAX_DIST = 128

CX_HEADS = 4
CX_HEAD_DIM = 128
CX_WIDTH = CX_HEADS * CX_HEAD_DIM

FFN_HIDDEN = ((8 * D_MODEL // 3 + 255) // 256) * 256

kernel_name = "hymba_style_diffattn_hgrn2_hybrid"


def rms_norm(x, g):
    xf = x.astype(jnp.float32)
    y = xf * lax.rsqrt(jnp.mean(xf * xf, axis=-1, keepdims=True) + NORM_EPS)
    return (y * g.astype(jnp.float32)).astype(x.dtype)


def t5_causal_bucket(dist):
    n = jnp.maximum(dist, 0)
    max_exact = REL_BUCKETS // 2
    nf = jnp.maximum(n, 1).astype(jnp.float32)
    large = max_exact + (jnp.log(nf / max_exact) / math.log(REL_MAX_DIST / max_exact)
                         * (REL_BUCKETS - max_exact)).astype(jnp.int32)
    large = jnp.minimum(large, REL_BUCKETS - 1)
    return jnp.where(n < max_exact, n, large)


def differential_attention(q, k, v, lam, lam_init, subln_g, rel_bias):
    B, S = q.shape[0], q.shape[1]
    n_blk = S // Q_BLOCK
    scale = DA_QK_DIM ** -0.5
    kt = jnp.transpose(k, (0, 2, 3, 1, 4))
    vt = jnp.transpose(v, (0, 2, 1, 3))
    qb = q.reshape(B, n_blk, Q_BLOCK, DA_HEADS, 2, DA_QK_DIM).transpose(1, 0, 3, 4, 2, 5)
    k_pos = jnp.arange(S)

    def block(args):
        q_blk, blk = args
        q_pos = blk * Q_BLOCK + jnp.arange(Q_BLOCK)
        dist = q_pos[:, None] - k_pos[None, :]
        bias = jnp.transpose(rel_bias[t5_causal_bucket(dist)], (2, 0, 1)).astype(jnp.float32)
        s = jnp.einsum('bhmqd,bhmkd->bhmqk', q_blk, kt).astype(jnp.float32) * scale + bias[None, :, None]
        s = jnp.where(dist >= 0, s, -jnp.inf)
        p = jax.nn.softmax(s, axis=-1)
        a = p[:, :, 0] - lam * p[:, :, 1]
        return jnp.einsum('bhqk,bhkd->bhqd', a.astype(vt.dtype), vt)

    o = lax.map(block, (qb, jnp.arange(n_blk)))
    o = rms_norm(o, subln_g) * (1.0 - lam_init)
    return o.transpose(1, 0, 3, 2, 4).reshape(B, S, DA_WIDTH)


def hgrn2(f_logit, q, i, g, lb, onorm_g):
    B, S = q.shape[0], q.shape[1]
    n_chunk = S // HG_CHUNK
    f = lb.astype(jnp.float32) + (1.0 - lb.astype(jnp.float32)) * jax.nn.sigmoid(f_logit.astype(jnp.float32))
    log_f = jnp.log(f)
    k = 1.0 - f

    def to_chunks(t, d):
        return t.astype(jnp.float32).reshape(B, n_chunk, HG_CHUNK, HG_HEADS, d).transpose(1, 0, 3, 2, 4)

    qc, kc, vc, gc = to_chunks(q, HG_DK), to_chunks(k, HG_DK), to_chunks(i, HG_DV), to_chunks(log_f, HG_DK)
    causal = jnp.tril(jnp.ones((HG_CHUNK, HG_CHUNK), dtype=bool))

    def step(state, inp):
        qt, kt, vt, gt = inp
        b = jnp.cumsum(gt, axis=2)
        diff = b[:, :, :, None, :] - b[:, :, None, :, :]
        decay = jnp.exp(jnp.where(causal[:, :, None], diff, -jnp.inf))
        attn = jnp.einsum('bhtc,bhsc,bhtsc->bhts', qt, kt, decay)
        o = (jnp.einsum('bhts,bhsv->bhtv', attn, vt)
             + jnp.einsum('bhtc,bhcv->bhtv', qt * jnp.exp(b), state))
        b_last = b[:, :, -1:, :]
        state = (jnp.exp(b_last[:, :, 0, :])[..., None] * state
                 + jnp.einsum('bhsc,bhsv->bhcv', kt * jnp.exp(b_last - b), vt))
        return state, o

    state0 = jnp.zeros((B, HG_HEADS, HG_DK, HG_DV), jnp.float32)
    _, outs = lax.scan(step, state0, (qc, kc, vc, gc))
    o = outs.transpose(1, 0, 3, 2, 4).reshape(B, S, HG_HEADS, HG_DV).astype(q.dtype)
    o = rms_norm(o, onorm_g) * jax.nn.silu(g.reshape(B, S, HG_HEADS, HG_DV))
    return o.reshape(B, S, HG_WIDTH)


def setup_inputs(seed: int = 0) -> dict:
    key = jax.random.key(seed)
    ks = jax.random.split(key, 24)

    def w(k, shape, fan_in):
        return jax.random.normal(k, shape, jnp.float32) * fan_in ** -0.5

    def gain(k, shape):
        return 1.0 + 0.02 * jax.random.normal(k, shape, jnp.float32)

    return {
        "x": jax.random.normal(ks[0], (BATCH, SEQ, D_MODEL), jnp.float32),
        "mem": jax.random.normal(ks[1], (BATCH, MEM_LEN, D_MODEL), jnp.float32),
        "w_in": w(ks[2], (DEPTH, D_MODEL, IN_COLS), D_MODEL),
        "w_out": w(ks[3], (DEPTH, MIX_WIDTH, D_MODEL), MIX_WIDTH),
        "w_cq": w(ks[4], (DEPTH, D_MODEL, CX_WIDTH), D_MODEL),
        "w_ckv": w(ks[5], (DEPTH, D_MODEL, 2 * CX_WIDTH), D_MODEL),
        "w_co": w(ks[6], (DEPTH, CX_WIDTH, D_MODEL), CX_WIDTH),
        "w_ffn_in": w(ks[7], (DEPTH, D_MODEL, 2 * FFN_HIDDEN), D_MODEL),
        "w_ffn_out": w(ks[8], (DEPTH, FFN_HIDDEN, D_MODEL), FFN_HIDDEN),
        "mix_pre_g": gain(ks[9], (DEPTH, D_MODEL)),
        "mix_post_g": gain(ks[10], (DEPTH, D_MODEL)),
        "cross_pre_g": gain(ks[11], (DEPTH, D_MODEL)),
        "cross_post_g": gain(ks[12], (DEPTH, D_MODEL)),
        "mem_norm_g": gain(ks[13], (DEPTH, D_MODEL)),
        "ffn_pre_g": gain(ks[14], (DEPTH, D_MODEL)),
        "ffn_post_g": gain(ks[15], (DEPTH, D_MODEL)),
        "da_subln_g": gain(ks[16], (DEPTH, DA_V_DIM)),
        "hg_onorm_g": gain(ks[17], (DEPTH, HG_DV)),
        "lambda_q1": 0.1 * jax.random.normal(ks[18], (DEPTH, DA_QK_DIM), jnp.float32),
        "lambda_k1": 0.1 * jax.random.normal(ks[19], (DEPTH, DA_QK_DIM), jnp.float32),
        "lambda_q2": 0.1 * jax.random.normal(ks[20], (DEPTH, DA_QK_DIM), jnp.float32),
        "lambda_k2": 0.1 * jax.random.normal(ks[21], (DEPTH, DA_QK_DIM), jnp.float32),
        "hg_lb_logits": 0.5 * jax.random.normal(ks[22], (DEPTH, HG_KEY_COLS), jnp.float32),
        "rel_bias": 0.1 * jax.random.normal(ks[23], (REL_BUCKETS, DA_HEADS), jnp.float32),
    }


def reference(x, mem, w_in, w_out, w_cq, w_ckv, w_co, w_ffn_in, w_ffn_out,
              mix_pre_g, mix_post_g, cross_pre_g, cross_post_g, mem_norm_g,
              ffn_pre_g, ffn_post_g, da_subln_g, hg_onorm_g,
              lambda_q1, lambda_k1, lambda_q2, lambda_k2, hg_lb_logits, rel_bias):
    B, S = x.shape[0], x.shape[1]
    M = mem.shape[1]
    lb_p = jax.nn.softmax(hg_lb_logits.astype(jnp.float32), axis=0)
    lower_bounds = jnp.cumsum(lb_p, axis=0) - lb_p[0:1]

    for l in range(DEPTH):
        h = rms_norm(x, mix_pre_g[l])
        proj = h @ w_in[l]
        q_da, k_da, v_da, f_hg, q_hg, i_hg, g_hg = jnp.split(proj, IN_SPLITS, axis=-1)

        lam_init = 0.8 - 0.6 * math.exp(-0.3 * l)
        lam = (jnp.exp(jnp.sum(lambda_q1[l].astype(jnp.float32) * lambda_k1[l].astype(jnp.float32)))
               - jnp.exp(jnp.sum(lambda_q2[l].astype(jnp.float32) * lambda_k2[l].astype(jnp.float32)))
               + lam_init)
        o_da = differential_attention(
            q_da.reshape(B, S, DA_HEADS, 2, DA_QK_DIM),
            k_da.reshape(B, S, DA_HEADS, 2, DA_QK_DIM),
            v_da.reshape(B, S, DA_HEADS, DA_V_DIM),
            lam, lam_init, da_subln_g[l], rel_bias)
        o_hg = hgrn2(f_hg, q_hg, i_hg, g_hg, lower_bounds[l], hg_onorm_g[l])
        mixed = jnp.concatenate([o_da, o_hg], axis=-1) @ w_out[l]
        x = x + rms_norm(mixed, mix_post_g[l])

        h = rms_norm(x, cross_pre_g[l])
        m = rms_norm(mem, mem_norm_g[l])
        qx = (h @ w_cq[l]).reshape(B, S, CX_HEADS, CX_HEAD_DIM)
        kv = (m @ w_ckv[l]).reshape(B, M, 2, CX_HEADS, CX_HEAD_DIM)
        s = jnp.einsum('bqhd,bkhd->bhqk', qx, kv[:, :, 0]).astype(jnp.float32) * CX_HEAD_DIM ** -0.5
        p = jax.nn.softmax(s, axis=-1)
        o = jnp.einsum('bhqk,bkhd->bqhd', p.astype(x.dtype), kv[:, :, 1]).reshape(B, S, CX_WIDTH)
        x = x + rms_norm(o @ w_co[l], cross_post_g[l])

        h = rms_norm(x, ffn_pre_g[l])
        gate, up = jnp.split(h @ w_ffn_in[l], 2, axis=-1)
        x = x + rms_norm((jax.nn.silu(gate) * up) @ w_ffn_out[l], ffn_post_g[l])

    return x
```

```cpp
#include <hip/hip_runtime.h>
#include <hip/hip_cooperative_groups.h>
#include <cstdio>
#include <cstdint>
namespace cg = cooperative_groups;
namespace pg8 {
#define PG8_LAS __attribute__((address_space(3)))
typedef unsigned short bf16_t;
typedef short bf16x8 __attribute__((ext_vector_type(8)));
typedef float f32x4 __attribute__((ext_vector_type(4)));
typedef unsigned u32x4 __attribute__((ext_vector_type(4)));
constexpr int BM = 256, BK = 64, HALF = 128, HTB = HALF * BK * 2  , STAGE_BYTES = 8 * HTB, NXCD = 8, WGM = 8;

__host__ __device__ __forceinline__ int lds_byte(int r, int c) { const int st = (r >> 4) * 2 + (c >> 5), rr = r & 15, cc = c & 31, ob = rr * 64 + cc * 2; return st * 1024 + (ob ^ (((ob >> 9) & 1) << 5)); }
__host__ __device__ __forceinline__ void stage_rc(int b, int& R, int& C) { const int st = b / 1024, sb = b % 1024, swz = sb ^ (((sb >> 9) & 1) << 5); R = (st >> 1) * 16 + swz / 64; C = (st & 1) * 32 + (swz % 64) / 2; }
__host__ __device__ __forceinline__ int perm32(int rho) { const int n = rho >> 4, i = rho & 15; return 8 * (i >> 2) + 4 * n + (i & 3); }

struct Unit { int pm, pn; };
struct Gemm { const bf16_t* A; const bf16_t* Bt; int M, N, K; };

struct StaticOrder {
    int nM, nN, nwg, G, c;
    __host__ __device__ void init(int M, int N, int G_, int c_) { nM = M / BM; nN = N / BM; nwg = nM * nN; G = G_; c = c_; }
    __host__ __device__ bool next(int i, Unit& u) const {
        const long L = (long)i * G + c; if (L >= nwg) return false;
        int wgid = (int)L; { const int q = nwg / NXCD, r = nwg % NXCD, xcd = wgid % NXCD, off = wgid / NXCD; wgid = (xcd < r ? xcd * (q + 1) : r * (q + 1) + (xcd - r) * q) + off; }
        const int nig = WGM * nN, gid = wgid / nig, fm = gid * WGM, gsz = (nM - fm) < WGM ? (nM - fm) : WGM;
        u.pm = fm + ((wgid % nig) % gsz); u.pn = (wgid % nig) / gsz; return true;
    }
    __device__ __forceinline__ void a_ready(const Unit&) const {}
    __device__ __forceinline__ void done(const Unit&) const {}
};
__device__ __forceinline__ unsigned cvt_pk_bf16(float lo, float hi) { unsigned r; asm volatile("v_cvt_pk_bf16_f32 %0, %1, %2" : "=v"(r) : "v"(lo), "v"(hi)); return r; }
typedef float f32x2 __attribute__((ext_vector_type(2)));
template <class Epi, class Sched, bool ALIGN_EPI = false, bool SP2 = false>
__device__ __forceinline__ void gemm_phase(PG8_LAS unsigned char* lds, const Gemm g, const Sched& S, const Epi& E, int tid_in) {
    int tid = tid_in; asm volatile("" : "+v"(tid)); const int wid = __builtin_amdgcn_readfirstlane(tid >> 6), lane = tid & 63, wr = wid >> 2, wc = wid & 3, fr = lane & 15, fq = lane >> 4;
    const int K = g.K, nt = K / BK;
    unsigned voffA[2], voffB[2];
#pragma unroll
    for (int i = 0; i < 2; ++i) { int R, C; stage_rc(tid * 16 + i * 8192, R, C); const int Rb = Epi::PERM ? ((R & ~31) + perm32(R & 31)) : R;
        voffA[i] = (unsigned)(R * K + C) * 2u; voffB[i] = (unsigned)(Rb * K + C) * 2u; }
    const size_t kstep = (size_t)(BK * 2);
    const size_t hstep = (size_t)HALF * K * 2;
    const size_t tstep = 2 * hstep;
    const unsigned ldsw = (unsigned)wid * 1024u;
    const int aoff = lds_byte(wr * 64 + fr, fq * 8), boff = lds_byte(wc * 32 + fr, fq * 8);
#define PG8_SA(b, h) (((b) * 2 + (h)) * HTB)
#define PG8_SB(b, h) ((4 + (b) * 2 + (h)) * HTB)
#define PG8_STAGE(bufoff, gbase, voff) do { _Pragma("unroll") for (int _i = 0; _i < 2; ++_i) \
        __builtin_amdgcn_global_load_lds((const unsigned*)((const char*)(gbase) + (voff)[_i]), (PG8_LAS unsigned*)(lds + (bufoff) + ldsw + _i * 8192), 16, 0, 0); } while (0)
#define PG8_LDA(dst, b, h) do { _Pragma("unroll") for (int m = 0; m < 4; ++m) _Pragma("unroll") for (int k = 0; k < 2; ++k) dst[m][k] = *(const PG8_LAS bf16x8*)(lds + PG8_SA(b, h) + aoff + m * 2048 + k * 1024); } while (0)
#define PG8_LDB(dst, b, h) do { _Pragma("unroll") for (int n = 0; n < 2; ++n) _Pragma("unroll") for (int k = 0; k < 2; ++k) dst[n][k] = *(const PG8_LAS bf16x8*)(lds + PG8_SB(b, h) + boff + n * 2048 + k * 1024); } while (0)
#define PG8_MMA(ai, bj, At, Bt) do { __builtin_amdgcn_s_setprio(1); _Pragma("unroll") for (int m = 0; m < 4; ++m) _Pragma("unroll") for (int n = 0; n < 2; ++n) _Pragma("unroll") for (int k = 0; k < 2; ++k) \
        acc[ai][bj][m][n] = __builtin_amdgcn_mfma_f32_16x16x32_bf16(Bt[n][k], At[m][k], acc[ai][bj][m][n], 0, 0, 0); __builtin_amdgcn_s_setprio(0); } while (0)
#define PG8_WAIT_V(n) asm volatile("s_waitcnt vmcnt(" #n ")" ::: "memory")
#define PG8_WAIT_L(n) asm volatile("s_waitcnt lgkmcnt(" #n ")" ::: "memory")
#define PG8_BAR __builtin_amdgcn_s_barrier()
#define PG8_SCHED __builtin_amdgcn_sched_barrier(0)
    Unit cur, nxt; int ui = 0;
    if (!S.next(0, cur)) return;
    f32x4 acc[2][2][4][2];
#pragma unroll
    for (int a = 0; a < 2; ++a)
#pragma unroll
        for (int b = 0; b < 2; ++b)
#pragma unroll
            for (int m = 0; m < 4; ++m)
#pragma unroll
                for (int n = 0; n < 2; ++n) acc[a][b][m][n] = (f32x4){0.f, 0.f, 0.f, 0.f};
    bf16x8 At[4][2], B0[2][2], B1[2][2];
    const char* cA = (const char*)g.A + (size_t)cur.pm * tstep; const char* cB = (const char*)g.Bt + (size_t)cur.pn * tstep;
    S.a_ready(cur);
    if constexpr (SP2) {
        PG8_STAGE(PG8_SB(0, 0), cB, voffB); PG8_STAGE(PG8_SB(0, 1), cB + hstep, voffB); PG8_STAGE(PG8_SA(0, 0), cA, voffA); PG8_STAGE(PG8_SA(0, 1), cA + hstep, voffA);
        if (wr == 1) PG8_BAR;
        PG8_WAIT_V(2); PG8_BAR;
        PG8_STAGE(PG8_SB(1, 0), cB + kstep, voffB); PG8_STAGE(PG8_SA(1, 0), cA + kstep, voffA); PG8_STAGE(PG8_SB(1, 1), cB + hstep + kstep, voffB);
        PG8_WAIT_V(6); PG8_BAR;
    } else {
        PG8_STAGE(PG8_SB(0, 0), cB, voffB); PG8_STAGE(PG8_SA(0, 0), cA, voffA); PG8_STAGE(PG8_SB(0, 1), cB + hstep, voffB); PG8_STAGE(PG8_SA(0, 1), cA + hstep, voffA);
        if (wr == 1) PG8_BAR;
        PG8_WAIT_V(4); PG8_BAR;
        PG8_STAGE(PG8_SB(1, 0), cB + kstep, voffB); PG8_STAGE(PG8_SA(1, 0), cA + kstep, voffA); PG8_STAGE(PG8_SB(1, 1), cB + hstep + kstep, voffB);
        PG8_WAIT_V(6); PG8_BAR;
    }
    for (;;) {
        const bool has_next = S.next(ui + 1, nxt);
        const char* nA = has_next ? (const char*)g.A + (size_t)nxt.pm * tstep : cA; const char* nB = has_next ? (const char*)g.Bt + (size_t)nxt.pn * tstep : cB;
        for (int t = 0; t < nt; t += 2) {
            const bool last = (t == nt - 2);
            const char* a1 = cA + (size_t)(t + 1) * kstep;
            const char* a2 = last ? nA : cA + (size_t)(t + 2) * kstep; const char* b2 = last ? nB : cB + (size_t)(t + 2) * kstep;
            const char* a3 = a2 + kstep; const char* b3 = b2 + kstep;
            if (last && has_next) S.a_ready(nxt);
            if constexpr (SP2) {
            PG8_LDB(B0, 0, 0); PG8_LDB(B1, 0, 1); PG8_SCHED; PG8_LDA(At, 0, 0); PG8_STAGE(PG8_SA(1, 1), a1 + hstep, voffA);
            PG8_WAIT_V(8); PG8_WAIT_L(0); PG8_BAR; PG8_MMA(0, 0, At, B0); PG8_MMA(0, 1, At, B1); PG8_BAR; PG8_SCHED;
            PG8_LDA(At, 0, 1); PG8_STAGE(PG8_SB(0, 0), b2, voffB); PG8_STAGE(PG8_SB(0, 1), b2 + hstep, voffB); PG8_STAGE(PG8_SA(0, 0), a2, voffA);
            PG8_WAIT_V(8); PG8_WAIT_L(0); PG8_BAR; PG8_MMA(1, 0, At, B0); PG8_MMA(1, 1, At, B1); PG8_BAR; PG8_SCHED;
            PG8_LDB(B0, 1, 0); PG8_LDB(B1, 1, 1); PG8_SCHED; PG8_LDA(At, 1, 0); PG8_STAGE(PG8_SA(0, 1), a2 + hstep, voffA);
            PG8_WAIT_V(8); PG8_WAIT_L(0); PG8_BAR; PG8_MMA(0, 0, At, B0); PG8_MMA(0, 1, At, B1); PG8_BAR; PG8_SCHED;
            PG8_LDA(At, 1, 1); PG8_STAGE(PG8_SB(1, 0), b3, voffB); PG8_STAGE(PG8_SB(1, 1), b3 + hstep, voffB); PG8_STAGE(PG8_SA(1, 0), a3, voffA);
            PG8_WAIT_V(8); PG8_WAIT_L(0); PG8_BAR; PG8_MMA(1, 0, At, B0); PG8_MMA(1, 1, At, B1); PG8_BAR; PG8_SCHED;
            } else {
            PG8_LDB(B0, 0, 0); PG8_SCHED; PG8_LDA(At, 0, 0); PG8_STAGE(PG8_SA(1, 1), a1 + hstep, voffA);
            PG8_WAIT_L(8); PG8_BAR; PG8_WAIT_L(0); PG8_MMA(0, 0, At, B0); PG8_BAR; PG8_SCHED;
            PG8_LDB(B1, 0, 1); PG8_STAGE(PG8_SB(0, 0), b2, voffB);
            PG8_BAR; PG8_WAIT_L(0); PG8_MMA(0, 1, At, B1); PG8_BAR;
            PG8_LDA(At, 0, 1); PG8_STAGE(PG8_SA(0, 0), a2, voffA);
            PG8_BAR; PG8_WAIT_L(0); PG8_MMA(1, 0, At, B0); PG8_BAR; PG8_SCHED;
            PG8_STAGE(PG8_SB(0, 1), b2 + hstep, voffB);
            PG8_WAIT_V(6); PG8_BAR; PG8_MMA(1, 1, At, B1); PG8_BAR;
            PG8_LDB(B0, 1, 0); PG8_SCHED; PG8_LDA(At, 1, 0); PG8_STAGE(PG8_SA(0, 1), a2 + hstep, voffA);
            PG8_WAIT_L(8); PG8_BAR; PG8_WAIT_L(0); PG8_MMA(0, 0, At, B0); PG8_BAR; PG8_SCHED;
            PG8_LDB(B1, 1, 1); PG8_STAGE(PG8_SB(1, 0), b3, voffB);
            PG8_BAR; PG8_WAIT_L(0); PG8_MMA(0, 1, At, B1); PG8_BAR;
            PG8_LDA(At, 1, 1); PG8_STAGE(PG8_SA(1, 0), a3, voffA);
            PG8_BAR; PG8_WAIT_L(0); PG8_MMA(1, 0, At, B0); PG8_BAR; PG8_SCHED;
            PG8_STAGE(PG8_SB(1, 1), b3 + hstep, voffB);
            PG8_WAIT_V(6); PG8_BAR; PG8_MMA(1, 1, At, B1); PG8_BAR;
            }
        }
        if constexpr (ALIGN_EPI) { if (wr == 0) PG8_BAR; }
        if constexpr (!Epi::AFTER_DRAIN) { E(acc, cur, wr, wc, fr, fq); S.done(cur); }
        if (!has_next) break;
#pragma unroll
        for (int a = 0; a < 2; ++a)
#pragma unroll
            for (int b = 0; b < 2; ++b)
#pragma unroll
                for (int m = 0; m < 4; ++m)
#pragma unroll
                    for (int n = 0; n < 2; ++n) acc[a][b][m][n] = (f32x4){0.f, 0.f, 0.f, 0.f};
        cur = nxt; cA = nA; cB = nB; ++ui;
        if constexpr (ALIGN_EPI) { if (wr == 1) PG8_BAR; }
    }
    PG8_WAIT_V(0);
    if constexpr (!ALIGN_EPI) { if (wr == 0) PG8_BAR; }
    PG8_BAR;
    if constexpr (Epi::AFTER_DRAIN) { E.fused(acc, cur, wr, wc, fr, fq, lds, wid, lane); S.done(cur); }
#undef PG8_SA
#undef PG8_SB
#undef PG8_STAGE
#undef PG8_LDA
#undef PG8_LDB
#undef PG8_MMA
#undef PG8_WAIT_V
#undef PG8_WAIT_L
#undef PG8_BAR
#undef PG8_SCHED
}
}

#define LAS __attribute__((address_space(3)))
#define DI __device__ __forceinline__
typedef unsigned short bf16;
typedef short bf16x8 __attribute__((ext_vector_type(8)));
typedef short s16x4 __attribute__((ext_vector_type(4)));
typedef float f32x4 __attribute__((ext_vector_type(4)));
typedef float f32x16 __attribute__((ext_vector_type(16)));
typedef unsigned u32x4 __attribute__((ext_vector_type(4)));
typedef unsigned u32x2 __attribute__((ext_vector_type(2)));
typedef short v4i16_t __attribute__((ext_vector_type(4)));

constexpr int T = 16384, DM = 2048, SEQ = 4096, INC = 7168, FH = 5632, MEMT = 1024, CXW = 512;
constexpr float EPS = 1e-6f, LOG2E = 1.4426950408889634f;
constexpr size_t MiB = 1u << 20;
constexpr size_t WS_WIN = 0, WS_WOUT = 28 * MiB, WS_WCQ = 36 * MiB, WS_WCKV = 38 * MiB, WS_WCO = 42 * MiB, WS_WFI = 44 * MiB, WS_WFO = 88 * MiB;
constexpr size_t WS_DEC = 110 * MiB, WS_LB = 111 * MiB, WS_H = 112 * MiB, WS_RD = 176 * MiB, WS_END = 496 * MiB;
constexpr size_t RD_MIX = 0, RD_QDA = 64 * MiB, RD_QHG = 96 * MiB, RD_KDA = 128 * MiB, RD_VDA = 160 * MiB, RD_IHG = 192 * MiB, RD_GHG = 224 * MiB, RD_LOGF = 256 * MiB;
constexpr size_t RD_Y = 192 * MiB, RD_HID = 0, RD_QX = 128 * MiB, RD_OX = 144 * MiB, RD_KV = 160 * MiB, RD_MN = 164 * MiB;
constexpr size_t WS_TBL = 111 * MiB + 256 * 1024;
constexpr size_t WS_BAR = 111 * MiB + 512 * 1024;
constexpr int LDS_BYTES = 147456, LDS_MISC = 131072 + 256;

DI float bf2f(bf16 b) { return __uint_as_float((unsigned)b << 16); }
typedef float f32x2_t __attribute__((ext_vector_type(2))); typedef __bf16 bf16x2_t __attribute__((ext_vector_type(2)));
DI unsigned pk2(float lo, float hi) { f32x2_t v = {lo, hi}; bf16x2_t b = __builtin_convertvector(v, bf16x2_t); return __builtin_bit_cast(unsigned, b); }
DI float fexp(float x) { return __builtin_amdgcn_exp2f(x * LOG2E); }
DI int lane_id_opaque() { unsigned m = ~0u; asm volatile("" : "+s"(m)); return (int)__builtin_amdgcn_mbcnt_hi(m, __builtin_amdgcn_mbcnt_lo(m, 0u)); }
DI float shflx(float v, int mask) { return __uint_as_float((unsigned)__builtin_amdgcn_ds_bpermute((lane_id_opaque() ^ mask) << 2, (int)__float_as_uint(v))); }
DI float xmax32(float v) { auto rr = __builtin_amdgcn_permlane32_swap(__float_as_uint(v), __float_as_uint(v), false, false); return fmaxf(__uint_as_float(rr[0]), __uint_as_float(rr[1])); }
DI float xsum32(float v) { auto rr = __builtin_amdgcn_permlane32_swap(__float_as_uint(v), __float_as_uint(v), false, false); return __uint_as_float(rr[0]) + __uint_as_float(rr[1]); }
DI float wave_sum(float v) {
#pragma unroll
    for (int o = 1; o < 64; o <<= 1) v += shflx(v, o);
    return v;
}
DI int crow(int i, int h) { return (i & 3) + 8 * (i >> 2) + 4 * h; }
#define LDS_WAIT() asm volatile("s_waitcnt lgkmcnt(0)" ::: "memory")

struct EpiF32 {
    static constexpr bool PERM = true, AFTER_DRAIN = false;
    float* O; int ldc;
    DI void operator()(const pg8::f32x4 (&acc)[2][2][4][2], const pg8::Unit& u, int wr, int wc, int fr, int fq) const {
        const int row0 = u.pm * 256 + wr * 64 + fr, col0 = u.pn * 256 + wc * 32 + 8 * fq;
#pragma unroll
        for (int ai = 0; ai < 2; ++ai)
#pragma unroll
            for (int m = 0; m < 4; ++m) { float* rowp = O + (size_t)(row0 + ai * 128 + m * 16) * ldc + col0;
#pragma unroll
                for (int bj = 0; bj < 2; ++bj) { *(f32x4*)(rowp + bj * 128) = acc[ai][bj][m][0]; *(f32x4*)(rowp + bj * 128 + 4) = acc[ai][bj][m][1]; } }
    }
};
struct EpiB16 {
    static constexpr bool PERM = true, AFTER_DRAIN = false;
    bf16* O; int ldc; float scale;
    DI void operator()(const pg8::f32x4 (&acc)[2][2][4][2], const pg8::Unit& u, int wr, int wc, int fr, int fq) const {
        const int row0 = u.pm * 256 + wr * 64 + fr, col0 = u.pn * 256 + wc * 32 + 8 * fq;
#pragma unroll
        for (int ai = 0; ai < 2; ++ai)
#pragma unroll
            for (int m = 0; m < 4; ++m) { bf16* rowp = O + (size_t)(row0 + ai * 128 + m * 16) * ldc + col0;
#pragma unroll
                for (int bj = 0; bj < 2; ++bj) { const pg8::f32x4 v0 = acc[ai][bj][m][0] * scale, v1 = acc[ai][bj][m][1] * scale;
                    u32x4 w; w.x = pk2(v0[0], v0[1]); w.y = pk2(v0[2], v0[3]); w.z = pk2(v1[0], v1[1]); w.w = pk2(v1[2], v1[3]);
                    *(u32x4*)(rowp + bj * 128) = w; } }
    }
};
struct EpiSwiGLU {
    static constexpr bool PERM = true, AFTER_DRAIN = false;
    bf16* O; int ldc;
    DI void operator()(const pg8::f32x4 (&acc)[2][2][4][2], const pg8::Unit& u, int wr, int wc, int fr, int fq) const {
        const int row0 = u.pm * 256 + wr * 64 + fr, col0 = u.pn * 128 + wc * 32 + 8 * fq;
#pragma unroll
        for (int ai = 0; ai < 2; ++ai)
#pragma unroll
            for (int m = 0; m < 4; ++m) { bf16* rowp = O + (size_t)(row0 + ai * 128 + m * 16) * ldc + col0;
                float r[8];
#pragma unroll
                for (int n = 0; n < 2; ++n)
#pragma unroll
                    for (int j = 0; j < 4; ++j) { const float gt = acc[ai][0][m][n][j], up = acc[ai][1][m][n][j]; r[n * 4 + j] = gt * up * __builtin_amdgcn_rcpf(1.f + fexp(-gt)); }
                u32x4 w; w.x = pk2(r[0], r[1]); w.y = pk2(r[2], r[3]); w.z = pk2(r[4], r[5]); w.w = pk2(r[6], r[7]);
                *(u32x4*)rowp = w; }
    }
};
struct EpiInProj {
    static constexpr bool PERM = true, AFTER_DRAIN = false;
    unsigned char* rd; const float* lb;
    DI void operator()(const pg8::f32x4 (&acc)[2][2][4][2], const pg8::Unit& u, int wr, int wc, int fr, int fq) const {
        const int seg = u.pn >> 2, row0 = u.pm * 256 + wr * 64 + fr, col0 = (u.pn & 3) * 256 + wc * 32 + 8 * fq;
        if (seg == 3) {
            float* O = (float*)(rd + RD_LOGF);
            float lbv[2][8];
#pragma unroll
            for (int bj = 0; bj < 2; ++bj)
#pragma unroll
                for (int j = 0; j < 8; ++j) lbv[bj][j] = lb[col0 + bj * 128 + j];
#pragma unroll
            for (int ai = 0; ai < 2; ++ai)
#pragma unroll
                for (int m = 0; m < 4; ++m) { float* rowp = O + (size_t)(row0 + ai * 128 + m * 16) * 1024 + col0;
#pragma unroll
                    for (int bj = 0; bj < 2; ++bj)
#pragma unroll
                        for (int n = 0; n < 2; ++n) { f32x4 o;
#pragma unroll
                            for (int j = 0; j < 4; ++j) { const float z = acc[ai][bj][m][n][j], l0 = lbv[bj][n * 4 + j];
                                const float sg = __builtin_amdgcn_rcpf(1.f + fexp(-z)); const float f = fmaxf(l0 + (1.f - l0) * sg, 1e-30f); o[j] = __logf(f); }
                            *(f32x4*)(rowp + bj * 128 + n * 4) = o; } }
        } else {
            const unsigned slot = (0x7630542u >> (4 * seg)) & 15u;
            const float sc = (seg == 0) ? 0.125f * LOG2E : 1.f;
            bf16* O = (bf16*)(rd + (size_t)slot * (32 * MiB));
#pragma unroll
            for (int ai = 0; ai < 2; ++ai)
#pragma unroll
                for (int m = 0; m < 4; ++m) { bf16* rowp = O + (size_t)(row0 + ai * 128 + m * 16) * 1024 + col0;
#pragma unroll
                    for (int bj = 0; bj < 2; ++bj) { const pg8::f32x4 v0 = acc[ai][bj][m][0] * sc, v1 = acc[ai][bj][m][1] * sc;
                        u32x4 w; w.x = pk2(v0[0], v0[1]); w.y = pk2(v0[2], v0[3]); w.z = pk2(v1[0], v1[1]); w.w = pk2(v1[2], v1[3]);
                        *(u32x4*)(rowp + bj * 128) = w; } }
        }
    }
};

template <int MODE> DI void transpose_item(const float* W, int K, int N, bf16* WT, LAS float* scr, int item, int lane) {
    const int nblk = N / 32, kb = item / nblk, nb = item % nblk, k0 = 64 * kb, n0 = 32 * nb;
    { float tmp[32]; const float* wp = W + (size_t)(k0 + (lane >> 5)) * N + n0 + (lane & 31);
#pragma unroll
      for (int i = 0; i < 32; ++i) tmp[i] = __builtin_nontemporal_load(wp + (size_t)(2 * i) * N);
#pragma unroll
      for (int i = 0; i < 32; ++i) scr[(2 * i + (lane >> 5)) * 33 + (lane & 31)] = tmp[i]; }
    LDS_WAIT(); asm volatile("" ::: "memory");
    const int c = lane & 7;
#pragma unroll
    for (int j = 0; j < 4; ++j) { const int n = (lane >> 3) + 8 * j; const LAS float* s = scr + (8 * c) * 33 + n;
        u32x4 o; o.x = pk2(s[0 * 33], s[1 * 33]); o.y = pk2(s[2 * 33], s[3 * 33]); o.z = pk2(s[4 * 33], s[5 * 33]); o.w = pk2(s[6 * 33], s[7 * 33]);
        int nn = n0 + n;
        if (MODE == 1) { if (nn < FH) nn = (nn >> 7) * 256 + (nn & 127); else { nn -= FH; nn = (nn >> 7) * 256 + 128 + (nn & 127); } }
        *(u32x4*)(WT + (size_t)nn * K + k0 + 8 * c) = o; }
    LDS_WAIT(); asm volatile("" ::: "memory");
}
DI void convert_weights(const float* const* in, int l, unsigned char* ws, LAS unsigned char* L, int gw, int NGW, int wave, int lane) {
    LAS float* scr = (LAS float*)(L + wave * 16384);
    constexpr int I_IN = 32 * (INC / 32), I_OUT = 32 * 64, I_CQ = 32 * 16, I_CKV = 32 * 32, I_CO = 8 * 64, I_FI = 32 * (2 * FH / 32), I_FO = (FH / 64) * 64;
    constexpr int NITEMS = I_IN + I_OUT + I_CQ + I_CKV + I_CO + I_FI + I_FO;
    for (int it = gw; it < NITEMS; it += NGW) {
        int r = it;
        if (r < I_IN) { transpose_item<0>(in[2] + (size_t)l * DM * INC, DM, INC, (bf16*)(ws + WS_WIN), scr, r, lane); continue; } r -= I_IN;
        if (r < I_OUT) { transpose_item<0>(in[3] + (size_t)l * DM * DM, DM, DM, (bf16*)(ws + WS_WOUT), scr, r, lane); continue; } r -= I_OUT;
        if (r < I_CQ) { transpose_item<0>(in[4] + (size_t)l * DM * CXW, DM, CXW, (bf16*)(ws + WS_WCQ), scr, r, lane); continue; } r -= I_CQ;
        if (r < I_CKV) { transpose_item<0>(in[5] + (size_t)l * DM * 1024, DM, 1024, (bf16*)(ws + WS_WCKV), scr, r, lane); continue; } r -= I_CKV;
        if (r < I_CO) { transpose_item<0>(in[6] + (size_t)l * CXW * DM, CXW, DM, (bf16*)(ws + WS_WCO), scr, r, lane); continue; } r -= I_CO;
        if (r < I_FI) { transpose_item<1>(in[7] + (size_t)l * DM * 2 * FH, DM, 2 * FH, (bf16*)(ws + WS_WFI), scr, r, lane); continue; } r -= I_FI;
        transpose_item<0>(in[8] + (size_t)l * FH * DM, FH, DM, (bf16*)(ws + WS_WFO), scr, r, lane);
    }
}

DI void norm_rows(const float* src, int nrows, const float* g, bf16* dst, int gw, int NGW, int lane) {
    int row = gw; if (row >= nrows) return;
    f32x4 v[8], vn[8];
    { const f32x4* xr = (const f32x4*)(src + (size_t)row * DM) + lane;
#pragma unroll
      for (int j = 0; j < 8; ++j) v[j] = __builtin_nontemporal_load(xr + 64 * j); }
    for (;;) {
        const int nrow = row + NGW; const bool has = nrow < nrows;
        if (has) { const f32x4* xr = (const f32x4*)(src + (size_t)nrow * DM) + lane;
#pragma unroll
            for (int j = 0; j < 8; ++j) vn[j] = __builtin_nontemporal_load(xr + 64 * j); }
        float ss = 0.f;
#pragma unroll
        for (int j = 0; j < 8; ++j) ss += (v[j].x * v[j].x + v[j].y * v[j].y) + (v[j].z * v[j].z + v[j].w * v[j].w);
        const float r = rsqrtf(wave_sum(ss) * (1.f / DM) + EPS);
        u32x2* o = (u32x2*)(dst + (size_t)row * DM) + lane;
#pragma unroll
        for (int j = 0; j < 8; ++j) { const f32x4 gg = ((const f32x4*)g)[lane + 64 * j]; u32x2 w; w.x = pk2(v[j].x * r * gg.x, v[j].y * r * gg.y); w.y = pk2(v[j].z * r * gg.z, v[j].w * r * gg.w); o[64 * j] = w; }
        if (!has) break;
#pragma unroll
        for (int j = 0; j < 8; ++j) v[j] = vn[j];
        row = nrow;
    }
}
DI void resnorm_rows(const float* Y, const float* Xs, float* Xd, const float* gpost, const float* gpre, bf16* H, int gw, int NGW, int lane) {
    int row = gw; if (row >= T) return;
    f32x4 y[8], x[8], yn[8], xn[8];
    { const f32x4* yr = (const f32x4*)(Y + (size_t)row * DM) + lane; const f32x4* xr = (const f32x4*)(Xs + (size_t)row * DM) + lane;
#pragma unroll
      for (int j = 0; j < 8; ++j) { y[j] = __builtin_nontemporal_load(yr + 64 * j); x[j] = __builtin_nontemporal_load(xr + 64 * j); } }
    for (;;) {
        const int nrow = row + NGW; const bool has = nrow < T;
        if (has) { const f32x4* yr = (const f32x4*)(Y + (size_t)nrow * DM) + lane; const f32x4* xr = (const f32x4*)(Xs + (size_t)nrow * DM) + lane;
#pragma unroll
            for (int j = 0; j < 8; ++j) { yn[j] = __builtin_nontemporal_load(yr + 64 * j); xn[j] = __builtin_nontemporal_load(xr + 64 * j); } }
        float ss = 0.f;
#pragma unroll
        for (int j = 0; j < 8; ++j) ss += (y[j].x * y[j].x + y[j].y * y[j].y) + (y[j].z * y[j].z + y[j].w * y[j].w);
        const float r = rsqrtf(wave_sum(ss) * (1.f / DM) + EPS);
        f32x4* xo = (f32x4*)(Xd + (size_t)row * DM) + lane; float s2 = 0.f;
#pragma unroll
        for (int j = 0; j < 8; ++j) { const f32x4 gg = ((const f32x4*)gpost)[lane + 64 * j]; x[j] = x[j] + y[j] * r * gg; __builtin_nontemporal_store(x[j], xo + 64 * j);
            s2 += (x[j].x * x[j].x + x[j].y * x[j].y) + (x[j].z * x[j].z + x[j].w * x[j].w); }
        if (H) {
            const float r2 = rsqrtf(wave_sum(s2) * (1.f / DM) + EPS);
            u32x2* o = (u32x2*)(H + (size_t)row * DM) + lane;
#pragma unroll
            for (int j = 0; j < 8; ++j) { const f32x4 gg = ((const f32x4*)gpre)[lane + 64 * j]; u32x2 w; w.x = pk2(x[j].x * r2 * gg.x, x[j].y * r2 * gg.y); w.y = pk2(x[j].z * r2 * gg.z, x[j].w * r2 * gg.w); o[64 * j] = w; }
        }
        if (!has) break;
#pragma unroll
        for (int j = 0; j < 8; ++j) { y[j] = yn[j]; x[j] = xn[j]; }
        row = nrow;
    }
}

DI void hg_state_units(LAS unsigned char* L, int u0, int G, const float* LOGF, const bf16* IHG, bf16* ST, float* DEC, int tid, int wave, int lane) {
    LAS bf16* KhT = (LAS bf16*)L;
    LAS bf16* Vs = (LAS bf16*)(L + 18432);
    LAS float* segtot = (LAS float*)(L + 38912);
    const int c = tid & 127, seg = tid >> 7;
    int unit = u0; if (unit >= 2048) return;
    float g[16]; bf16x8 v8[2];
#define HGS_LOAD(u_) do { const int bh_ = (u_) >> 6, n_ = (u_) & 63; const size_t tk_ = (size_t)(bh_ >> 3) * SEQ + n_ * 64; const int hc_ = (bh_ & 7) * 128; \
        _Pragma("unroll") for (int i = 0; i < 16; ++i) g[i] = LOGF[(tk_ + 16 * seg + i) * 1024 + hc_ + c]; \
        _Pragma("unroll") for (int i = 0; i < 2; ++i) { const int cid = tid + 512 * i, kv = cid >> 4, dvs = (cid & 15) * 8; v8[i] = *(const bf16x8*)(IHG + (tk_ + kv) * 1024 + hc_ + dvs); } } while (0)
    HGS_LOAD(unit);
    for (;;) {
        float tot = 0.f;
#pragma unroll
        for (int i = 0; i < 16; ++i) tot += g[i];
        segtot[seg * 128 + c] = tot;
#pragma unroll
        for (int i = 0; i < 2; ++i) { const int cid = tid + 512 * i, kv = cid >> 4, dvs = (cid & 15) * 8; *(LAS bf16x8*)(Vs + kv * 160 + dvs) = v8[i]; }
        __syncthreads();
        float off = 0.f, total = 0.f;
#pragma unroll
        for (int s = 0; s < 4; ++s) { const float t_ = segtot[s * 128 + c]; if (s < seg) off += t_; total += t_; }
        float run = off; float kh[16];
#pragma unroll
        for (int i = 0; i < 16; ++i) { run += g[i]; kh[i] = (1.f - fexp(g[i])) * fexp(total - run); }
        { u32x4 w0, w1; w0.x = pk2(kh[0], kh[1]); w0.y = pk2(kh[2], kh[3]); w0.z = pk2(kh[4], kh[5]); w0.w = pk2(kh[6], kh[7]);
          w1.x = pk2(kh[8], kh[9]); w1.y = pk2(kh[10], kh[11]); w1.z = pk2(kh[12], kh[13]); w1.w = pk2(kh[14], kh[15]);
          *(LAS u32x4*)(KhT + c * 72 + 16 * seg) = w0; *(LAS u32x4*)(KhT + c * 72 + 16 * seg + 8) = w1; }
        if (seg == 0) DEC[(size_t)unit * 128 + c] = fexp(total);
        const int nunit = unit + G; const bool has = nunit < 2048;
        if (has) HGS_LOAD(nunit);
        __syncthreads();
        const int lr = lane & 15, quad = lane >> 4;
        bf16x8 bfr[2];
#pragma unroll
        for (int ks = 0; ks < 2; ++ks) { const LAS bf16* vp = Vs + (32 * ks + quad * 8 + (lr >> 2)) * 160 + 16 * wave + 4 * (lr & 3);
            const s16x4 lo = __builtin_bit_cast(s16x4, __builtin_amdgcn_ds_read_tr16_b64_v4i16((LAS v4i16_t*)vp)), hi = __builtin_bit_cast(s16x4, __builtin_amdgcn_ds_read_tr16_b64_v4i16((LAS v4i16_t*)(vp + 4 * 160)));
            bfr[ks] = __builtin_shufflevector(lo, hi, 0, 1, 2, 3, 4, 5, 6, 7); }
        bf16* dst = ST + (size_t)unit * 16384 + (size_t)(16 * wave + lr) * 128 + quad * 4;
#pragma unroll
        for (int ct = 0; ct < 8; ++ct) {
            pg8::f32x4 acc = {0.f, 0.f, 0.f, 0.f};
#pragma unroll
            for (int ks = 0; ks < 2; ++ks) { const bf16x8 a = *(const LAS bf16x8*)(KhT + (16 * ct + lr) * 72 + 32 * ks + quad * 8); acc = __builtin_amdgcn_mfma_f32_16x16x32_bf16(a, bfr[ks], acc, 0, 0, 0); }
            u32x2 w; w.x = pk2(acc[0], acc[1]); w.y = pk2(acc[2], acc[3]); *(u32x2*)(dst + 16 * ct) = w;
        }
        __syncthreads();
        if (!has) break;
        unit = nunit;
    }
#undef HGS_LOAD
}
DI void hg_scan(bf16* ST, const float* DEC, int gtid, int NTH) {
    for (int e = gtid; e < 32 * 4096; e += NTH) {
        const int bh = e >> 12, rem = e & 4095, dv = rem >> 5, c = (rem & 31) * 4;
        f32x4 S = {0.f, 0.f, 0.f, 0.f};
        bf16* p = ST + (size_t)bh * 64 * 16384 + dv * 128 + c; const float* dp = DEC + (size_t)bh * 64 * 128 + c;
#pragma unroll 8
        for (int n = 0; n < 64; ++n) {
            const u32x2 u = *(const u32x2*)(p + (size_t)n * 16384); const f32x4 d = *(const f32x4*)(dp + n * 128);
            u32x2 w; w.x = pk2(S.x, S.y); w.y = pk2(S.z, S.w); *(u32x2*)(p + (size_t)n * 16384) = w;
            f32x4 uf; uf.x = __uint_as_float(u.x << 16); uf.y = __uint_as_float(u.x & 0xffff0000u); uf.z = __uint_as_float(u.y << 16); uf.w = __uint_as_float(u.y & 0xffff0000u);
            S = d * S + uf;
        }
    }
}
DI void hg_out_units(LAS unsigned char* L, int u0, int G, const float* LOGF, const bf16* QHG, const bf16* IHG, const bf16* GHG, const bf16* ST, const float* og, bf16* MIX, int tid, int wave, int lane) {
    LAS bf16* Qt = (LAS bf16*)L;
    LAS bf16* Kt = (LAS bf16*)(L + 17408);
    LAS bf16* Qh = (LAS bf16*)(L + 34816);
    LAS bf16* Vs = (LAS bf16*)(L + 52224);
    LAS bf16* At = (LAS bf16*)(L + 72704);
    LAS float* segtot = (LAS float*)(L + 81920);
    LAS float* ssq = (LAS float*)(L + 83968);
    int lr, quad;
    for (int unit = u0; unit < 2048; unit += G) {
    int t0_ = tid, l1_ = lane; asm volatile("" : "+v"(t0_), "+v"(l1_));
    const int c = t0_ & 127, seg = t0_ >> 7; lr = l1_ & 15; quad = l1_ >> 4;
    const int bh = unit >> 6, n = unit & 63, b_ = bh >> 3, h = bh & 7; const size_t tok0 = (size_t)b_ * SEQ + n * 64;
    float g[16]; bf16 qraw[16]; bf16x8 v8[2];
#pragma unroll
    for (int i = 0; i < 16; ++i) { g[i] = LOGF[(tok0 + 16 * seg + i) * 1024 + h * 128 + c]; qraw[i] = QHG[(tok0 + 16 * seg + i) * 1024 + h * 128 + c]; }
#pragma unroll
    for (int i = 0; i < 2; ++i) { const int cid = t0_ + 512 * i, kv = cid >> 4, dvs = (cid & 15) * 8; v8[i] = *(const bf16x8*)(IHG + (tok0 + kv) * 1024 + h * 128 + dvs); }
    u32x2 gtv[4]; bf16x8 stf[4];
#pragma unroll
    for (int tt = 0; tt < 4; ++tt) gtv[tt] = *(const u32x2*)(GHG + (tok0 + 16 * tt + lr) * 1024 + h * 128 + 16 * wave + quad * 4);
    { const bf16* sp = ST + (size_t)unit * 16384 + (size_t)(16 * wave + lr) * 128 + quad * 8;
#pragma unroll
      for (int ks = 0; ks < 4; ++ks) stf[ks] = *(const bf16x8*)(sp + 32 * ks); }
    float tot = 0.f;
#pragma unroll
    for (int i = 0; i < 16; ++i) tot += g[i];
    segtot[seg * 128 + c] = tot;
#pragma unroll
    for (int i = 0; i < 2; ++i) { const int cid = t0_ + 512 * i, kv = cid >> 4, dvs = (cid & 15) * 8; *(LAS bf16x8*)(Vs + kv * 160 + dvs) = v8[i]; }
    __syncthreads();
    float off = 0.f;
#pragma unroll
    for (int s = 0; s < 4; ++s) { const float t_ = segtot[s * 128 + c]; if (s < seg) off += t_; }
    const float bmid = segtot[c] + segtot[128 + c];
    float run = off;
#pragma unroll
    for (int i = 0; i < 16; ++i) { const int s = 16 * seg + i; run += g[i];
        const float qv = bf2f(qraw[i]); const float kk = 1.f - fexp(g[i]);
        Qt[s * 136 + c] = (bf16)(pk2(qv * fexp(run - bmid), 0.f) & 0xffffu);
        Kt[s * 136 + c] = (bf16)(pk2(kk * fexp(bmid - run), 0.f) & 0xffffu);
        Qh[s * 136 + c] = (bf16)(pk2(qv * fexp(run), 0.f) & 0xffffu); }
    __syncthreads();
#pragma unroll
    for (int e = 0; e < 2; ++e) { const int id = 2 * wave + e, tt = id >> 2, stl = id & 3;
        pg8::f32x4 acc = {0.f, 0.f, 0.f, 0.f};
        if (stl <= tt) {
#pragma unroll
            for (int ks = 0; ks < 4; ++ks) { const bf16x8 a = *(const LAS bf16x8*)(Kt + (16 * stl + lr) * 136 + 32 * ks + quad * 8); const bf16x8 b = *(const LAS bf16x8*)(Qt + (16 * tt + lr) * 136 + 32 * ks + quad * 8);
                acc = __builtin_amdgcn_mfma_f32_16x16x32_bf16(a, b, acc, 0, 0, 0); }
            const int tpos = 16 * tt + lr, s0 = 16 * stl + quad * 4;
#pragma unroll
            for (int j = 0; j < 4; ++j) acc[j] = (s0 + j <= tpos) ? acc[j] : 0.f;
        }
        u32x2 w; w.x = pk2(acc[0], acc[1]); w.y = pk2(acc[2], acc[3]); *(LAS u32x2*)(At + (16 * tt + lr) * 72 + 16 * stl + quad * 4) = w; }
    __syncthreads();
    bf16x8 vfr[2];
#pragma unroll
    for (int ks = 0; ks < 2; ++ks) { const LAS bf16* vp = Vs + (32 * ks + quad * 8 + (lr >> 2)) * 160 + 16 * wave + 4 * (lr & 3);
        const s16x4 lo = __builtin_bit_cast(s16x4, __builtin_amdgcn_ds_read_tr16_b64_v4i16((LAS v4i16_t*)vp)), hi = __builtin_bit_cast(s16x4, __builtin_amdgcn_ds_read_tr16_b64_v4i16((LAS v4i16_t*)(vp + 4 * 160)));
        vfr[ks] = __builtin_shufflevector(lo, hi, 0, 1, 2, 3, 4, 5, 6, 7); }
    pg8::f32x4 acc[4];
#pragma unroll
    for (int tt = 0; tt < 4; ++tt) { acc[tt] = (pg8::f32x4){0.f, 0.f, 0.f, 0.f};
#pragma unroll
        for (int ks = 0; ks < 2; ++ks) { const bf16x8 bA = *(const LAS bf16x8*)(At + (16 * tt + lr) * 72 + 32 * ks + quad * 8); acc[tt] = __builtin_amdgcn_mfma_f32_16x16x32_bf16(vfr[ks], bA, acc[tt], 0, 0, 0); }
#pragma unroll
        for (int ks = 0; ks < 4; ++ks) { const bf16x8 bQ = *(const LAS bf16x8*)(Qh + (16 * tt + lr) * 136 + 32 * ks + quad * 8); acc[tt] = __builtin_amdgcn_mfma_f32_16x16x32_bf16(stf[ks], bQ, acc[tt], 0, 0, 0); }
        float ss = (acc[tt][0] * acc[tt][0] + acc[tt][1] * acc[tt][1]) + (acc[tt][2] * acc[tt][2] + acc[tt][3] * acc[tt][3]);
        ss += shflx(ss, 16); ss += shflx(ss, 32);
        if (quad == 0) ssq[(16 * tt + lr) * 8 + wave] = ss; }
    __syncthreads();
    const f32x4 gn = *(const f32x4*)(og + 16 * wave + quad * 4);
#pragma unroll
    for (int tt = 0; tt < 4; ++tt) { const LAS f32x4* sq = (const LAS f32x4*)(ssq + (16 * tt + lr) * 8); const f32x4 s0 = sq[0], s1 = sq[1];
        const float r = rsqrtf(((s0.x + s0.y) + (s0.z + s0.w) + (s1.x + s1.y) + (s1.z + s1.w)) * (1.f / 128.f) + EPS);
        const u32x2 gt = gtv[tt];
        float gv[4] = {__uint_as_float(gt.x << 16), __uint_as_float(gt.x & 0xffff0000u), __uint_as_float(gt.y << 16), __uint_as_float(gt.y & 0xffff0000u)};
        float o[4];
#pragma unroll
        for (int j = 0; j < 4; ++j) o[j] = acc[tt][j] * r * gn[j] * gv[j] * __builtin_amdgcn_rcpf(1.f + fexp(-gv[j]));
        u32x2 w; w.x = pk2(o[0], o[1]); w.y = pk2(o[2], o[3]); *(u32x2*)(MIX + (tok0 + 16 * tt + lr) * DM + 1024 + h * 128 + 16 * wave + quad * 4) = w; }
    __syncthreads();
    }
}

constexpr int ATT_KP = 136, ATT_VP = 160, ATT_KSLOT = 64 * ATT_KP * 2, ATT_VSLOT = 64 * ATT_VP * 2;
template <bool DIFF, int ND0> DI void att_qk_softmax(const LAS unsigned char* Kc, const bf16x8 (&qf)[ND0], const LAS float* tbl, int t, int qbase, int r, int h_, bool act1,
                                                      float& m_run, float& l_run, f32x16& negm, f32x16 (&y)[4], bf16x8 (&pf)[2][2]) {
    f32x16 p[2];
#pragma unroll
    for (int sub = 0; sub < 2; ++sub) {
        p[sub] = negm;
        if (sub == 0 || act1) {
#pragma unroll
            for (int d0 = 0; d0 < ND0; ++d0) { const bf16x8 kf = *(const LAS bf16x8*)(Kc + (32 * sub * ATT_KP + 16 * d0) * 2);
                p[sub] = __builtin_amdgcn_mfma_f32_32x32x16_bf16(kf, qf[d0], p[sub], 0, 0, 0); }
        }
    }
    const bool far = !DIFF || (qbase - (64 * t + 63) >= 128);
    if (!far) {
        const int qpos = qbase + r;
#pragma unroll
        for (int sub = 0; sub < 2; ++sub)
#pragma unroll
            for (int i = 0; i < 16; ++i) { const int dist = qpos - (64 * t + 32 * sub + crow(i, h_));
                const int idx = dist < 0 ? 0 : (dist > 255 ? 255 : dist); float s = p[sub][i] + tbl[idx]; s = dist >= 0 ? s : -INFINITY;
                if (sub == 1 && !act1) s = -INFINITY;
                p[sub][i] = s; }
    }
    float mx = -INFINITY;
#pragma unroll
    for (int sub = 0; sub < 2; ++sub)
#pragma unroll
        for (int i = 0; i < 16; ++i) mx = fmaxf(mx, p[sub][i]);
    mx = xmax32(mx);
    if (t == 0 || __any(mx > 8.f)) {
        const float dl = (t == 0) ? mx : fmaxf(mx, 0.f), alpha = __builtin_amdgcn_exp2f(-dl);
        m_run += dl; l_run *= alpha;
#pragma unroll
        for (int i = 0; i < 16; ++i) { negm[i] = -m_run; p[0][i] -= dl; p[1][i] -= dl; }
#pragma unroll
        for (int d0 = 0; d0 < 4; ++d0)
#pragma unroll
            for (int i = 0; i < 16; ++i) y[d0][i] *= alpha;
    }
    float rs = 0.f;
#pragma unroll
    for (int sub = 0; sub < 2; ++sub)
#pragma unroll
        for (int i = 0; i < 16; ++i) { const float e = __builtin_amdgcn_exp2f(p[sub][i]); p[sub][i] = e; rs += e; }
    l_run += rs;
#pragma unroll
    for (int sub = 0; sub < 2; ++sub)
#pragma unroll
        for (int s = 0; s < 2; ++s) { u32x4 pw; pw.x = pk2(p[sub][8 * s], p[sub][8 * s + 1]); pw.y = pk2(p[sub][8 * s + 2], p[sub][8 * s + 3]); pw.z = pk2(p[sub][8 * s + 4], p[sub][8 * s + 5]); pw.w = pk2(p[sub][8 * s + 6], p[sub][8 * s + 7]);
            pf[sub][s] = __builtin_bit_cast(bf16x8, pw); }
}
DI void att_pv(const LAS unsigned char* Vc, const bf16x8 (&pf)[2][2], f32x16 (&y)[4], bool act1) {
#pragma unroll
    for (int sub = 0; sub < 2; ++sub) {
        if (sub == 0 || act1) {
#pragma unroll
            for (int s = 0; s < 2; ++s) {
            __builtin_amdgcn_sched_barrier(0);
#pragma unroll
                for (int d0 = 0; d0 < 4; ++d0) { const LAS unsigned char* vp = Vc + ((32 * sub + 16 * s) * ATT_VP + 32 * d0) * 2;
                    const s16x4 lo = __builtin_bit_cast(s16x4, __builtin_amdgcn_ds_read_tr16_b64_v4i16((LAS v4i16_t*)vp));
                    const s16x4 hi = __builtin_bit_cast(s16x4, __builtin_amdgcn_ds_read_tr16_b64_v4i16((LAS v4i16_t*)(vp + 8 * ATT_VP * 2)));
                    const bf16x8 vf = __builtin_shufflevector(lo, hi, 0, 1, 2, 3, 4, 5, 6, 7);
                    y[d0] = __builtin_amdgcn_mfma_f32_32x32x16_bf16(vf, pf[sub][s], y[d0], 0, 0, 0); }
            }
        }
    }
    __builtin_amdgcn_sched_barrier(0);
}
template <bool DIFF> DI void attn_unit(LAS unsigned char* L, const bf16* Qh, int qpitch, const bf16* Kh, const bf16* Vh, int kvpitch, bf16* Oh, int opitch,
                                       size_t qrow0, int qpos0, size_t kvrow0, int NT, const float* relb_h  , float lam, float postscale, const float* subg,
                                       int tid, int wave, int lane) {
    constexpr int ND0 = DIFF ? 4 : 8;
    constexpr int KP = ATT_KP, VP = ATT_VP, KSLOT = ATT_KSLOT, VSLOT = ATT_VSLOT;
    LAS float* tbl = (LAS float*)(L + 2 * KSLOT + 3 * VSLOT);
    LAS float* exch = (LAS float*)L;
    const int r = lane & 31, h_ = lane >> 5, g_ = (lane >> 4) & 1, q_ = (lane & 15) >> 2, p_ = lane & 3;
    const int wq0 = DIFF ? (wave >> 1) * 32 : wave * 32, kcol = DIFF ? (wave & 1) * 64 : 0;
    const bool stag = wave >= 4;
    bf16x8 qf[ND0];
    { const bf16* qp = Qh + (qrow0 + wq0 + r) * (size_t)qpitch + kcol + 8 * h_;
#pragma unroll
      for (int d0 = 0; d0 < ND0; ++d0) qf[d0] = *(const bf16x8*)(qp + 16 * d0); }
    f32x16 y[4];
#pragma unroll
    for (int d0 = 0; d0 < 4; ++d0)
#pragma unroll
        for (int i = 0; i < 16; ++i) y[d0][i] = 0.f;
    float m_run = 0.f, l_run = 0.f;
    f32x16 negm;
#pragma unroll
    for (int i = 0; i < 16; ++i) negm[i] = 0.f;
    bf16x8 kreg[2], vreg[2];
    const int skv0 = tid >> 4, scol = (tid & 15) * 8;
    const int loff = skv0 * kvpitch + scol;
#define ATT_LOAD(t) do { const int tw_ = DIFF ? (t) : ((t) & 3); const bf16* Kt_ = Kh + (kvrow0 + (size_t)tw_ * 64) * kvpitch; const bf16* Vt_ = Vh + (kvrow0 + (size_t)tw_ * 64) * kvpitch; \
        _Pragma("unroll") for (int i_ = 0; i_ < 2; ++i_) { kreg[i_] = *(const bf16x8*)(Kt_ + loff + 32 * i_ * kvpitch); vreg[i_] = *(const bf16x8*)(Vt_ + loff + 32 * i_ * kvpitch); } } while (0)
#define ATT_STORE(ks, vs) do { _Pragma("unroll") for (int i_ = 0; i_ < 2; ++i_) { const int kv_ = skv0 + 32 * i_; \
        *(LAS bf16x8*)(L + (ks) * KSLOT + (kv_ * KP + scol) * 2) = kreg[i_]; *(LAS bf16x8*)(L + 2 * KSLOT + (vs) * VSLOT + (kv_ * VP + scol) * 2) = vreg[i_]; } } while (0)
    ATT_LOAD(0);
    float tb_ = 0.f; if (DIFF && tid < 256) tb_ = relb_h[tid];
    ATT_STORE(0, 0);
    if (NT > 1) ATT_LOAD(1);
    if (DIFF && tid < 256) tbl[tid] = tb_;
    __syncthreads();
    const int koff = ((r * KP) + kcol + 8 * h_) * 2;
    const int voff = 2 * KSLOT + ((4 * h_ + q_) * VP + 16 * g_ + 4 * p_) * 2;
    bf16x8 pf[2][2]; bool pa0 = false, pa1 = false;
#pragma unroll
    for (int a = 0; a < 2; ++a)
#pragma unroll
        for (int b = 0; b < 2; ++b) pf[a][b] = (bf16x8){0, 0, 0, 0, 0, 0, 0, 0};
    int vcur = 0, vprev = 2;
    const int qbase = qpos0 + wq0, qlast = qbase + 31;
    for (int t = 0; t < NT; ++t) {
        const int cur = t & 1, vnext = (vcur == 2) ? 0 : vcur + 1;
        if (t + 1 < NT) ATT_STORE(cur ^ 1, vnext);
        if (t + 2 < NT) ATT_LOAD(t + 2);
        const LAS unsigned char* Kc = L + cur * KSLOT + koff;
        const bool act0 = !DIFF || (64 * t <= qlast), act1 = !DIFF || (64 * t + 32 <= qlast);
        if (stag && pa0) att_pv(L + voff + vprev * VSLOT, pf, y, pa1);
        if (act0) att_qk_softmax<DIFF, ND0>(Kc, qf, tbl, t, qbase, r, h_, act1, m_run, l_run, negm, y, pf);
        if (!stag && act0) att_pv(L + voff + vcur * VSLOT, pf, y, act1);
        pa0 = act0; pa1 = act1;
        vprev = vcur; vcur = vnext;
        __syncthreads();
    }
    if (stag && pa0) att_pv(L + voff + vprev * VSLOT, pf, y, pa1);
    __syncthreads();
#undef ATT_LOAD
#undef ATT_STORE
    const float inv = 1.f / xsum32(l_run);
    int le_ = lane; asm volatile("" : "+v"(le_));
    const int r_e = le_ & 31, h_e = le_ >> 5;
    bf16* orow = Oh + (qrow0 + wq0 + r_e) * (size_t)opitch;
    if (DIFF) {
        const int qs = wave >> 1, mp = wave & 1;
        if (mp == 1) {
#pragma unroll
            for (int d0 = 0; d0 < 4; ++d0)
#pragma unroll
                for (int i = 0; i < 16; ++i) exch[((qs * 4 + d0) * 16 + i) * 64 + le_] = y[d0][i] * inv;
        }
        __syncthreads();
        if (mp == 0) {
            float ss = 0.f;
#pragma unroll
            for (int d0 = 0; d0 < 4; ++d0)
#pragma unroll
                for (int i = 0; i < 16; ++i) { const float o = y[d0][i] * inv - lam * exch[((qs * 4 + d0) * 16 + i) * 64 + le_]; y[d0][i] = o; ss += o * o; }
            ss += shflx(ss, 32);
            const float rr = rsqrtf(ss * (1.f / 128.f) + EPS) * postscale;
#pragma unroll
            for (int d0 = 0; d0 < 4; ++d0)
#pragma unroll
                for (int g = 0; g < 4; ++g) { const int dv0 = 32 * d0 + 8 * g + 4 * h_e; const f32x4 sg = *(const f32x4*)(subg + dv0);
                    u32x2 w; w.x = pk2(y[d0][4 * g] * rr * sg.x, y[d0][4 * g + 1] * rr * sg.y); w.y = pk2(y[d0][4 * g + 2] * rr * sg.z, y[d0][4 * g + 3] * rr * sg.w);
                    *(u32x2*)(orow + dv0) = w; }
        }
    } else {
#pragma unroll
        for (int d0 = 0; d0 < 4; ++d0)
#pragma unroll
            for (int g = 0; g < 4; ++g) { const int dv0 = 32 * d0 + 8 * g + 4 * h_e;
                u32x2 w; w.x = pk2(y[d0][4 * g] * inv, y[d0][4 * g + 1] * inv); w.y = pk2(y[d0][4 * g + 2] * inv, y[d0][4 * g + 3] * inv);
                *(u32x2*)(orow + dv0) = w; }
    }
    __syncthreads();
}

#define XB_TMO      128
#define XB_XCNT(j)  (256  + 64 * (j))
#define XB_XSUB(j)  (1280 + 64 * (j))
#define XB_XGEN(j)  (2304 + 64 * (j))
#define XB_TOP      3328
#define XB_TOPGEN   3392
#define XCD_BAR_WORDS 3456
#define XB_SPIN_CAP (1u << 18)

__device__ __forceinline__ unsigned xb_ld(unsigned* p)              { return __hip_atomic_load(p, __ATOMIC_RELAXED, __HIP_MEMORY_SCOPE_AGENT); }
__device__ __forceinline__ unsigned xb_add(unsigned* p, unsigned v) { return __hip_atomic_fetch_add(p, v, __ATOMIC_RELAXED, __HIP_MEMORY_SCOPE_AGENT); }
__device__ __forceinline__ unsigned xb_xcc_id() { return (unsigned)__builtin_amdgcn_s_getreg((3 << 11) | 20) & 0xFu; }
#define XB_SPIN(cond, bar) do { unsigned _sp = 0; while (cond) { __builtin_amdgcn_s_sleep(1); \
    if ((++_sp & 255u) == 0u) { if (xb_ld(&(bar)[XB_TMO])) break; if (_sp > XB_SPIN_CAP) { atomicAdd(&(bar)[XB_TMO], 1u); break; } } } } while (0)

struct XcdBarrier {
    unsigned* bar; unsigned x;
    volatile LAS unsigned* st;
};

__device__ __forceinline__ XcdBarrier xcd_barrier_post(unsigned* bar, volatile LAS unsigned* st, int xtid) {
    XcdBarrier b; b.bar = bar; b.x = xb_xcc_id(); b.st = st;
    if (xtid == 0) (void)xb_add(&bar[XB_XCNT(b.x)], 1u);
    return b;
}
__device__ __forceinline__ void xcd_barrier_complete(unsigned* bar, unsigned x, unsigned& nloc, unsigned& nx) {
    const unsigned G = gridDim.x * gridDim.y * gridDim.z;
    unsigned sum, cnt, mine, sp = 0u;
    for (;;) {
        sum = 0u; cnt = 0u; mine = 0u;
#pragma unroll
        for (unsigned j = 0; j < 16; ++j) { const unsigned c = xb_ld(&bar[XB_XCNT(j)]); sum += c; cnt += (c > 0u) ? 1u : 0u; mine = (j == x) ? c : mine; }
        if (sum == G) break;
        __builtin_amdgcn_s_sleep(1);
        if ((++sp & 255u) == 0u) { if (xb_ld(&bar[XB_TMO])) break; if (sp > XB_SPIN_CAP) { atomicAdd(&bar[XB_TMO], 1u); break; } }
    }
    nloc = mine > 0u ? mine : 1u; nx = cnt > 0u ? cnt : 1u;
}

__device__ __forceinline__ void xcd_barrier(const XcdBarrier& b, int xtid) {
    asm volatile("s_waitcnt vmcnt(0)" ::: "memory");
    __syncthreads();
    if (xtid == 0) {
        unsigned* bar = b.bar;
        __builtin_amdgcn_s_waitcnt(0);
        unsigned nloc = b.st[0], nx = b.st[1];
        if (nloc == 0u) { xcd_barrier_complete(bar, b.x, nloc, nx); b.st[0] = nloc; b.st[1] = nx; }
        const unsigned old = xb_add(&bar[XB_XSUB(b.x)], 1u);
        const unsigned gen = old / nloc;
        if (old + 1u == (gen + 1u) * nloc) {
            __builtin_amdgcn_fence(__ATOMIC_RELEASE, "agent");
            asm volatile("s_waitcnt vmcnt(0)" ::: "memory");
            const unsigned og = xb_add(&bar[XB_TOP], 1u);
            const unsigned tg = og / nx;
            if (og + 1u == (tg + 1u) * nx) xb_add(&bar[XB_TOPGEN], 1u);
            else XB_SPIN(xb_ld(&bar[XB_TOPGEN]) == tg, bar);
            __builtin_amdgcn_fence(__ATOMIC_ACQUIRE, "agent");
            xb_add(&bar[XB_XGEN(b.x)], 1u);
            asm volatile("s_waitcnt vmcnt(0)" ::: "memory");
        } else {
            XB_SPIN(xb_ld(&bar[XB_XGEN(b.x)]) == gen, bar);
            __builtin_amdgcn_fence(__ATOMIC_ACQUIRE, "agent");
            asm volatile("s_waitcnt vmcnt(0)" ::: "memory");
        }
    }
    __syncthreads();
}

struct Params { const float* in[24]; float* out; unsigned char* ws; };


template <class Epi> DI void run_gemm(LAS unsigned char* L, int tid, const bf16* A, const bf16* Bt, int M, int N, int K, const Epi& E, int shift = 0) {
    pg8::Gemm g{A, Bt, M, N, K}; pg8::StaticOrder S; S.init(M, N, (int)gridDim.x, (int)((blockIdx.x + shift) % gridDim.x));
    pg8::gemm_phase<Epi, pg8::StaticOrder, true, true>(L, g, S, E, tid);
}

__global__ void __launch_bounds__(512, 2) mega_fwd(Params P) {
    extern __shared__ __attribute__((aligned(16))) unsigned char lds_raw[];
    LAS unsigned char* L = (LAS unsigned char*)lds_raw;
    cg::grid_group grid = cg::this_grid();
    const int G = gridDim.x, bid = blockIdx.x, NGW = G * 8, NTH = G * 512;
    const int wave0 = __builtin_amdgcn_readfirstlane((int)(threadIdx.x >> 6));
#define TIDX() (wave0 * 64 + lane_id_opaque())
#define PH_BEGIN() int tid = wave0 * 64 + lane_id_opaque(); long zoff_ = 0; asm volatile("" : "+v"(tid), "+s"(zoff_)); unsigned char* ws = P.ws + zoff_; \
    const int lane = tid & 63, wave = __builtin_amdgcn_readfirstlane(tid >> 6), gw = bid * 8 + wave, gtid = bid * 512 + tid; unsigned char* rd = ws + WS_RD; \
    (void)lane; (void)wave; (void)gw; (void)gtid; (void)rd;
#define X (P.out)
    volatile LAS unsigned* MISC = (volatile LAS unsigned*)(L + LDS_MISC);
    { const int t0 = TIDX(); if (t0 < 2) MISC[t0] = 0u;
      unsigned* barw = (unsigned*)(P.ws + WS_BAR);
      if (bid == 0) for (int i = t0; i < XCD_BAR_WORDS; i += 512) barw[i] = 0u; }
    __syncthreads();
#define GRID_SYNC() do { asm volatile("s_waitcnt vmcnt(0) lgkmcnt(0)" ::: "memory"); grid.sync(); } while (0)
#define XSYNC() do { XcdBarrier xb_; xb_.bar = (unsigned*)(P.ws + WS_BAR); xb_.x = xb_xcc_id(); xb_.st = (volatile LAS unsigned*)(L + LDS_MISC); xcd_barrier(xb_, TIDX()); } while (0)

    { PH_BEGIN();
      convert_weights(P.in, 0, ws, L, gw, NGW, wave, lane);
      float* LB = (float*)(ws + WS_LB);
      { float* TBL = (float*)(ws + WS_TBL);
        for (int i = gtid; i < 2048; i += NTH) { const int hh = i >> 8, nn = i & 255; int bk;
            if (nn < 16) bk = nn; else { bk = 16 + (int)(__logf((float)nn * (1.f / 16.f)) / 2.0794415416798357f * 16.f); bk = bk > 31 ? 31 : bk; }
            TBL[i] = (P.in[23][bk * 8 + hh] - P.in[23][31 * 8 + hh]) * LOG2E; } }
      for (int i = gtid; i < 2048; i += NTH) { const int c = i & 1023; LB[i] = (i < 1024) ? 0.f : 1.f / (1.f + fexp(P.in[22][c] - P.in[22][1024 + c])); }
      norm_rows(P.in[0], T, P.in[9], (bf16*)(ws + WS_H), gw, NGW, lane); }
    GRID_SYNC();
    (void)xcd_barrier_post((unsigned*)(P.ws + WS_BAR), (volatile LAS unsigned*)(L + LDS_MISC), TIDX());

    for (int l = 0; l < 2; ++l) {
        { PH_BEGIN(); EpiInProj E{rd, (const float*)(ws + WS_LB) + l * 1024}; run_gemm(L, tid, (const bf16*)(ws + WS_H), (const bf16*)(ws + WS_WIN), T, INC, DM, E); }
        XSYNC();
        { PH_BEGIN();
          hg_state_units(L, bid, G, (const float*)(rd + RD_LOGF), (const bf16*)(rd + RD_IHG), (bf16*)(ws + WS_H), (float*)(ws + WS_DEC), tid, wave, lane); }
        { PH_BEGIN();
            const float lam_init = (l == 0) ? 0.2f : (0.8f - 0.6f * 0.7408182206817179f);
            const float a1 = wave_sum(P.in[18][l * 64 + lane] * P.in[19][l * 64 + lane]), a2 = wave_sum(P.in[20][l * 64 + lane] * P.in[21][l * 64 + lane]);
            const float lam = __uint_as_float(__builtin_amdgcn_readfirstlane(__float_as_uint(fexp(a1) - fexp(a2) + lam_init)));
            const int vcu = (G == 256) ? (((bid & 7) << 5) | (bid >> 3)) : bid;
            for (int sidx = vcu; sidx < 1024; sidx += G) {
                const int i = sidx >> 8, v = sidx & 255, bh = v >> 3, s = v & 7, b_ = bh >> 3, h = bh & 7;
                const int qb = (i == 0) ? s : (i == 1) ? 15 - s : (i == 2) ? 16 + s : 31 - s;
                attn_unit<true>(L, (const bf16*)(rd + RD_QDA) + h * 128, 1024, (const bf16*)(rd + RD_KDA) + h * 128, (const bf16*)(rd + RD_VDA) + h * 128, 1024, (bf16*)(rd + RD_MIX) + h * 128, DM,
                                (size_t)b_ * SEQ + qb * 128, qb * 128, (size_t)b_ * SEQ, 2 * qb + 2, (const float*)(ws + WS_TBL) + h * 256, lam, 1.f - lam_init, P.in[16] + l * 128, tid, wave, lane);
            }
        }
        XSYNC();
        { PH_BEGIN(); hg_scan((bf16*)(ws + WS_H), (const float*)(ws + WS_DEC), gtid, NTH); }
        XSYNC();
        { PH_BEGIN();
          hg_out_units(L, bid, G, (const float*)(rd + RD_LOGF), (const bf16*)(rd + RD_QHG), (const bf16*)(rd + RD_IHG), (const bf16*)(rd + RD_GHG), (const bf16*)(ws + WS_H), P.in[17] + l * 128, (bf16*)(rd + RD_MIX), tid, wave, lane); }
        XSYNC();
        { PH_BEGIN(); EpiF32 E{(float*)(rd + RD_Y), DM}; run_gemm(L, tid, (const bf16*)(rd + RD_MIX), (const bf16*)(ws + WS_WOUT), T, DM, DM, E); }
        XSYNC();
        { PH_BEGIN();
          resnorm_rows((const float*)(rd + RD_Y), l == 0 ? P.in[0] : X, X, P.in[10] + l * DM, P.in[11] + l * DM, (bf16*)(ws + WS_H), gw, NGW, lane);
          norm_rows(P.in[1], MEMT, P.in[13] + l * DM, (bf16*)(rd + RD_MN), gw, NGW, lane); }
        XSYNC();
        { PH_BEGIN(); EpiB16 E{(bf16*)(rd + RD_QX), CXW, 0.08838834764831845f * LOG2E}; run_gemm(L, tid, (const bf16*)(ws + WS_H), (const bf16*)(ws + WS_WCQ), T, CXW, DM, E); }
        { PH_BEGIN(); EpiB16 E{(bf16*)(rd + RD_KV), 1024, 1.f}; run_gemm(L, tid, (const bf16*)(rd + RD_MN), (const bf16*)(ws + WS_WCKV), MEMT, 1024, DM, E, G / 2); }
        XSYNC();
        { PH_BEGIN();
          for (int u = (G == 256) ? (((bid & 7) << 5) | (bid >> 3)) : bid; u < 256; u += G) { const int b_ = u >> 6, h = (u >> 4) & 3, qb = u & 15; const bf16* KV = (const bf16*)(rd + RD_KV);
            attn_unit<false>(L, (const bf16*)(rd + RD_QX) + h * 128, CXW, KV + h * 128, KV + 512 + h * 128, 1024, (bf16*)(rd + RD_OX) + h * 128, CXW,
                             (size_t)b_ * SEQ + qb * 256, 0, (size_t)b_ * 256, 4, nullptr, 0.f, 1.f, nullptr, tid, wave, lane); } }
        XSYNC();
        { PH_BEGIN(); EpiF32 E{(float*)(rd + RD_Y), DM}; run_gemm(L, tid, (const bf16*)(rd + RD_OX), (const bf16*)(ws + WS_WCO), T, DM, CXW, E); }
        XSYNC();
        { PH_BEGIN(); resnorm_rows((const float*)(rd + RD_Y), X, X, P.in[12] + l * DM, P.in[14] + l * DM, (bf16*)(ws + WS_H), gw, NGW, lane); }
        XSYNC();
        { PH_BEGIN(); EpiSwiGLU E{(bf16*)(rd + RD_HID), FH}; run_gemm(L, tid, (const bf16*)(ws + WS_H), (const bf16*)(ws + WS_WFI), T, 2 * FH, DM, E); }
        XSYNC();
        { PH_BEGIN(); EpiF32 E{(float*)(rd + RD_Y), DM}; run_gemm(L, tid, (const bf16*)(rd + RD_HID), (const bf16*)(ws + WS_WFO), T, DM, FH, E); }
        XSYNC();
        if (l == 0) {
            { PH_BEGIN(); resnorm_rows((const float*)(rd + RD_Y), X, X, P.in[15] + l * DM, P.in[9] + DM, (bf16*)(ws + WS_H), gw, NGW, lane); }
            { PH_BEGIN(); convert_weights(P.in, 1, ws, L, gw, NGW, wave, lane); }
            XSYNC();
        } else {
            { PH_BEGIN(); resnorm_rows((const float*)(rd + RD_Y), X, X, P.in[15] + l * DM, nullptr, nullptr, gw, NGW, lane); }
        }
    }
}

extern "C" void kernel_launch(void* const* d_in, const int* in_sizes, int n_in, void* d_out, int out_size, void* d_ws, size_t ws_size, hipStream_t stream) {
    static int grid = 0;
    if (grid == 0) {
        if (n_in != 24 || out_size != T * DM || ws_size < WS_END) { fprintf(stderr, "kernel_launch: unexpected problem (n_in %d out %d ws %zu)\n", n_in, out_size, ws_size); grid = -1; return; }
        int dev = 0, cus = 0, per_cu = 0;
        hipGetDevice(&dev); hipDeviceGetAttribute(&cus, hipDeviceAttributeMultiprocessorCount, dev);
        hipFuncSetAttribute((const void*)mega_fwd, hipFuncAttributeMaxDynamicSharedMemorySize, LDS_BYTES);
        hipOccupancyMaxActiveBlocksPerMultiprocessor(&per_cu, (const void*)mega_fwd, 512, LDS_BYTES);
        if (per_cu < 1) { fprintf(stderr, "kernel_launch: occupancy query says %d blocks per CU\n", per_cu); per_cu = 1; }
        (void)hipGetLastError();
        grid = cus;
    }
    if (grid < 0) return;
    Params p{};
    for (int i = 0; i < 24; ++i) p.in[i] = (const float*)d_in[i];
    p.out = (float*)d_out; p.ws = (unsigned char*)d_ws;
    void* args[] = {&p};
    hipError_t e = hipLaunchCooperativeKernel((const void*)mega_fwd, dim3(grid), dim3(512), args, LDS_BYTES, stream);
    if (e != hipSuccess) fprintf(stderr, "cooperative launch failed: %s (grid %d)\n", hipGetErrorString(e), grid);
}
```

```cpp
#include <hip/hip_runtime.h>
#include <hip/hip_cooperative_groups.h>
#include <cstdio>
#include <cstdint>
namespace cg = cooperative_groups;
namespace pg8 {
#define PG8_LAS __attribute__((address_space(3)))
typedef unsigned short bf16_t;
typedef short bf16x8 __attribute__((ext_vector_type(8)));
typedef float f32x4 __attribute__((ext_vector_type(4)));
typedef unsigned u32x4 __attribute__((ext_vector_type(4)));
constexpr int BM = 256, BK = 64, HALF = 128, HTB = HALF * BK * 2  , STAGE_BYTES = 8 * HTB, NXCD = 8, WGM = 8;

__host__ __device__ __forceinline__ int lds_byte(int r, int c) { const int st = (r >> 4) * 2 + (c >> 5), rr = r & 15, cc = c & 31, ob = rr * 64 + cc * 2; return st * 1024 + (ob ^ (((ob >> 9) & 1) << 5)); }
__host__ __device__ __forceinline__ void stage_rc(int b, int& R, int& C) { const int st = b / 1024, sb = b % 1024, swz = sb ^ (((sb >> 9) & 1) << 5); R = (st >> 1) * 16 + swz / 64; C = (st & 1) * 32 + (swz % 64) / 2; }
__host__ __device__ __forceinline__ int perm32(int rho) { const int n = rho >> 4, i = rho & 15; return 8 * (i >> 2) + 4 * n + (i & 3); }

struct Unit { int pm, pn; };
struct Gemm { const bf16_t* A; const bf16_t* Bt; int M, N, K; };

struct StaticOrder {
    int nM, nN, nwg, G, c;
    __host__ __device__ void init(int M, int N, int G_, int c_) { nM = M / BM; nN = N / BM; nwg = nM * nN; G = G_; c = c_; }
    __host__ __device__ bool next(int i, Unit& u) const {
        const long L = (long)i * G + c; if (L >= nwg) return false;
        int wgid = (int)L; { const int q = nwg / NXCD, r = nwg % NXCD, xcd = wgid % NXCD, off = wgid / NXCD; wgid = (xcd < r ? xcd * (q + 1) : r * (q + 1) + (xcd - r) * q) + off; }
        const int nig = WGM * nN, gid = wgid / nig, fm = gid * WGM, gsz = (nM - fm) < WGM ? (nM - fm) : WGM;
        u.pm = fm + ((wgid % nig) % gsz); u.pn = (wgid % nig) / gsz; return true;
    }
    __device__ __forceinline__ void a_ready(const Unit&) const {}
    __device__ __forceinline__ void done(const Unit&) const {}
};
__device__ __forceinline__ unsigned cvt_pk_bf16(float lo, float hi) { unsigned r; asm volatile("v_cvt_pk_bf16_f32 %0, %1, %2" : "=v"(r) : "v"(lo), "v"(hi)); return r; }
typedef float f32x2 __attribute__((ext_vector_type(2)));
template <class Epi, class Sched, bool ALIGN_EPI = false, bool SP2 = false>
__device__ __forceinline__ void gemm_phase(PG8_LAS unsigned char* lds, const Gemm g, const Sched& S, const Epi& E, int tid_in) {
    int tid = tid_in; asm volatile("" : "+v"(tid)); const int wid = __builtin_amdgcn_readfirstlane(tid >> 6), lane = tid & 63, wr = wid >> 2, wc = wid & 3, fr = lane & 15, fq = lane >> 4;
    const int K = g.K, nt = K / BK;
    unsigned voffA[2], voffB[2];
#pragma unroll
    for (int i = 0; i < 2; ++i) { int R, C; stage_rc(tid * 16 + i * 8192, R, C); const int Rb = Epi::PERM ? ((R & ~31) + perm32(R & 31)) : R;
        voffA[i] = (unsigned)(R * K + C) * 2u; voffB[i] = (unsigned)(Rb * K + C) * 2u; }
    const size_t kstep = (size_t)(BK * 2);
    const size_t hstep = (size_t)HALF * K * 2;
    const size_t tstep = 2 * hstep;
    const unsigned ldsw = (unsigned)wid * 1024u;
    const int aoff = lds_byte(wr * 64 + fr, fq * 8), boff = lds_byte(wc * 32 + fr, fq * 8);
#define PG8_SA(b, h) (((b) * 2 + (h)) * HTB)
#define PG8_SB(b, h) ((4 + (b) * 2 + (h)) * HTB)
#define PG8_STAGE(bufoff, gbase, voff) do { _Pragma("unroll") for (int _i = 0; _i < 2; ++_i) \
        __builtin_amdgcn_global_load_lds((const unsigned*)((const char*)(gbase) + (voff)[_i]), (PG8_LAS unsigned*)(lds + (bufoff) + ldsw + _i * 8192), 16, 0, 0); } while (0)
#define PG8_LDA(dst, b, h) do { _Pragma("unroll") for (int m = 0; m < 4; ++m) _Pragma("unroll") for (int k = 0; k < 2; ++k) dst[m][k] = *(const PG8_LAS bf16x8*)(lds + PG8_SA(b, h) + aoff + m * 2048 + k * 1024); } while (0)
#define PG8_LDB(dst, b, h) do { _Pragma("unroll") for (int n = 0; n < 2; ++n) _Pragma("unroll") for (int k = 0; k < 2; ++k) dst[n][k] = *(const PG8_LAS bf16x8*)(lds + PG8_SB(b, h) + boff + n * 2048 + k * 1024); } while (0)
#define PG8_MMA(ai, bj, At, Bt) do { __builtin_amdgcn_s_setprio(1); _Pragma("unroll") for (int m = 0; m < 4; ++m) _Pragma("unroll") for (int n = 0; n < 2; ++n) _Pragma("unroll") for (int k = 0; k < 2; ++k) \
        acc[ai][bj][m][n] = __builtin_amdgcn_mfma_f32_16x16x32_bf16(Bt[n][k], At[m][k], acc[ai][bj][m][n], 0, 0, 0); __builtin_amdgcn_s_setprio(0); } while (0)
#define PG8_WAIT_V(n) asm volatile("s_waitcnt vmcnt(" #n ")" ::: "memory")
#define PG8_WAIT_L(n) asm volatile("s_waitcnt lgkmcnt(" #n ")" ::: "memory")
#define PG8_BAR __builtin_amdgcn_s_barrier()
#define PG8_SCHED __builtin_amdgcn_sched_barrier(0)
    Unit cur, nxt; int ui = 0;
    if (!S.next(0, cur)) return;
    f32x4 acc[2][2][4][2];
#pragma unroll
    for (int a = 0; a < 2; ++a)
#pragma unroll
        for (int b = 0; b < 2; ++b)
#pragma unroll
            for (int m = 0; m < 4; ++m)
#pragma unroll
                for (int n = 0; n < 2; ++n) acc[a][b][m][n] = (f32x4){0.f, 0.f, 0.f, 0.f};
    bf16x8 At[4][2], B0[2][2], B1[2][2];
    const char* cA = (const char*)g.A + (size_t)cur.pm * tstep; const char* cB = (const char*)g.Bt + (size_t)cur.pn * tstep;
    S.a_ready(cur);
    if constexpr (SP2) {
        PG8_STAGE(PG8_SB(0, 0), cB, voffB); PG8_STAGE(PG8_SB(0, 1), cB + hstep, voffB); PG8_STAGE(PG8_SA(0, 0), cA, voffA); PG8_STAGE(PG8_SA(0, 1), cA + hstep, voffA);
        if (wr == 1) PG8_BAR;
        PG8_WAIT_V(2); PG8_BAR;
        PG8_STAGE(PG8_SB(1, 0), cB + kstep, voffB); PG8_STAGE(PG8_SA(1, 0), cA + kstep, voffA); PG8_STAGE(PG8_SB(1, 1), cB + hstep + kstep, voffB);
        PG8_WAIT_V(6); PG8_BAR;
    } else {
        PG8_STAGE(PG8_SB(0, 0), cB, voffB); PG8_STAGE(PG8_SA(0, 0), cA, voffA); PG8_STAGE(PG8_SB(0, 1), cB + hstep, voffB); PG8_STAGE(PG8_SA(0, 1), cA + hstep, voffA);
        if (wr == 1) PG8_BAR;
        PG8_WAIT_V(4); PG8_BAR;
        PG8_STAGE(PG8_SB(1, 0), cB + kstep, voffB); PG8_STAGE(PG8_SA(1, 0), cA + kstep, voffA); PG8_STAGE(PG8_SB(1, 1), cB + hstep + kstep, voffB);
        PG8_WAIT_V(6); PG8_BAR;
    }
    for (;;) {
        const bool has_next = S.next(ui + 1, nxt);
        const char* nA = has_next ? (const char*)g.A + (size_t)nxt.pm * tstep : cA; const char* nB = has_next ? (const char*)g.Bt + (size_t)nxt.pn * tstep : cB;
        for (int t = 0; t < nt; t += 2) {
            const bool last = (t == nt - 2);
            const char* a1 = cA + (size_t)(t + 1) * kstep;
            const char* a2 = last ? nA : cA + (size_t)(t + 2) * kstep; const char* b2 = last ? nB : cB + (size_t)(t + 2) * kstep;
            const char* a3 = a2 + kstep; const char* b3 = b2 + kstep;
            if (last && has_next) S.a_ready(nxt);
            if constexpr (SP2) {
            PG8_LDB(B0, 0, 0); PG8_LDB(B1, 0, 1); PG8_SCHED; PG8_LDA(At, 0, 0); PG8_STAGE(PG8_SA(1, 1), a1 + hstep, voffA);
            PG8_WAIT_V(8); PG8_WAIT_L(0); PG8_BAR; PG8_MMA(0, 0, At, B0); PG8_MMA(0, 1, At, B1); PG8_BAR; PG8_SCHED;
            PG8_LDA(At, 0, 1); PG8_STAGE(PG8_SB(0, 0), b2, voffB); PG8_STAGE(PG8_SB(0, 1), b2 + hstep, voffB); PG8_STAGE(PG8_SA(0, 0), a2, voffA);
            PG8_WAIT_V(8); PG8_WAIT_L(0); PG8_BAR; PG8_MMA(1, 0, At, B0); PG8_MMA(1, 1, At, B1); PG8_BAR; PG8_SCHED;
            PG8_LDB(B0, 1, 0); PG8_LDB(B1, 1, 1); PG8_SCHED; PG8_LDA(At, 1, 0); PG8_STAGE(PG8_SA(0, 1), a2 + hstep, voffA);
            PG8_WAIT_V(8); PG8_WAIT_L(0); PG8_BAR; PG8_MMA(0, 0, At, B0); PG8_MMA(0, 1, At, B1); PG8_BAR; PG8_SCHED;
            PG8_LDA(At, 1, 1); PG8_STAGE(PG8_SB(1, 0), b3, voffB); PG8_STAGE(PG8_SB(1, 1), b3 + hstep, voffB); PG8_STAGE(PG8_SA(1, 0), a3, voffA);
            PG8_WAIT_V(8); PG8_WAIT_L(0); PG8_BAR; PG8_MMA(1, 0, At, B0); PG8_MMA(1, 1, At, B1); PG8_BAR; PG8_SCHED;
            } else {
            PG8_LDB(B0, 0, 0); PG8_SCHED; PG8_LDA(At, 0, 0); PG8_STAGE(PG8_SA(1, 1), a1 + hstep, voffA);
            PG8_WAIT_L(8); PG8_BAR; PG8_WAIT_L(0); PG8_MMA(0, 0, At, B0); PG8_BAR; PG8_SCHED;
            PG8_LDB(B1, 0, 1); PG8_STAGE(PG8_SB(0, 0), b2, voffB);
            PG8_BAR; PG8_WAIT_L(0); PG8_MMA(0, 1, At, B1); PG8_BAR;
            PG8_LDA(At, 0, 1); PG8_STAGE(PG8_SA(0, 0), a2, voffA);
            PG8_BAR; PG8_WAIT_L(0); PG8_MMA(1, 0, At, B0); PG8_BAR; PG8_SCHED;
            PG8_STAGE(PG8_SB(0, 1), b2 + hstep, voffB);
            PG8_WAIT_V(6); PG8_BAR; PG8_MMA(1, 1, At, B1); PG8_BAR;
            PG8_LDB(B0, 1, 0); PG8_SCHED; PG8_LDA(At, 1, 0); PG8_STAGE(PG8_SA(0, 1), a2 + hstep, voffA);
            PG8_WAIT_L(8); PG8_BAR; PG8_WAIT_L(0); PG8_MMA(0, 0, At, B0); PG8_BAR; PG8_SCHED;
            PG8_LDB(B1, 1, 1); PG8_STAGE(PG8_SB(1, 0), b3, voffB);
            PG8_BAR; PG8_WAIT_L(0); PG8_MMA(0, 1, At, B1); PG8_BAR;
            PG8_LDA(At, 1, 1); PG8_STAGE(PG8_SA(1, 0), a3, voffA);
            PG8_BAR; PG8_WAIT_L(0); PG8_MMA(1, 0, At, B0); PG8_BAR; PG8_SCHED;
            PG8_STAGE(PG8_SB(1, 1), b3 + hstep, voffB);
            PG8_WAIT_V(6); PG8_BAR; PG8_MMA(1, 1, At, B1); PG8_BAR;
            }
        }
        if constexpr (ALIGN_EPI) { if (wr == 0) PG8_BAR; }
        if constexpr (!Epi::AFTER_DRAIN) { E(acc, cur, wr, wc, fr, fq); S.done(cur); }
        if (!has_next) break;
#pragma unroll
        for (int a = 0; a < 2; ++a)
#pragma unroll
            for (int b = 0; b < 2; ++b)
#pragma unroll
                for (int m = 0; m < 4; ++m)
#pragma unroll
                    for (int n = 0; n < 2; ++n) acc[a][b][m][n] = (f32x4){0.f, 0.f, 0.f, 0.f};
        cur = nxt; cA = nA; cB = nB; ++ui;
        if constexpr (ALIGN_EPI) { if (wr == 1) PG8_BAR; }
    }
    PG8_WAIT_V(0);
    if constexpr (!ALIGN_EPI) { if (wr == 0) PG8_BAR; }
    PG8_BAR;
    if constexpr (Epi::AFTER_DRAIN) { E.fused(acc, cur, wr, wc, fr, fq, lds, wid, lane); S.done(cur); }
#undef PG8_SA
#undef PG8_SB
#undef PG8_STAGE
#undef PG8_LDA
#undef PG8_LDB
#undef PG8_MMA
#undef PG8_WAIT_V
#undef PG8_WAIT_L
#undef PG8_BAR
#undef PG8_SCHED
}
}

#define LAS __attribute__((address_space(3)))
#define DI __device__ __forceinline__
typedef unsigned short bf16;
typedef short bf16x8 __attribute__((ext_vector_type(8)));
typedef short s16x4 __attribute__((ext_vector_type(4)));
typedef float f32x4 __attribute__((ext_vector_type(4)));
typedef float f32x16 __attribute__((ext_vector_type(16)));
typedef unsigned u32x4 __attribute__((ext_vector_type(4)));
typedef unsigned u32x2 __attribute__((ext_vector_type(2)));
typedef short v4i16_t __attribute__((ext_vector_type(4)));

constexpr int T = 16384, DM = 2048, SEQ = 4096, INC = 7168, FH = 5632, MEMT = 1024, CXW = 512;
constexpr float EPS = 1e-6f, LOG2E = 1.4426950408889634f;
constexpr size_t MiB = 1u << 20;
constexpr size_t WS_WIN = 0, WS_WOUT = 28 * MiB, WS_WCQ = 36 * MiB, WS_WCKV = 38 * MiB, WS_WCO = 42 * MiB, WS_WFI = 44 * MiB, WS_WFO = 88 * MiB;
constexpr size_t WS_DEC = 110 * MiB, WS_LB = 111 * MiB, WS_H = 112 * MiB, WS_RD = 176 * MiB, WS_END = 496 * MiB;
constexpr size_t RD_MIX = 0, RD_QDA = 64 * MiB, RD_QHG = 96 * MiB, RD_KDA = 128 * MiB, RD_VDA = 160 * MiB, RD_IHG = 192 * MiB, RD_GHG = 224 * MiB, RD_LOGF = 256 * MiB;
constexpr size_t RD_Y = 192 * MiB, RD_HID = 0, RD_QX = 128 * MiB, RD_OX = 144 * MiB, RD_KV = 160 * MiB, RD_MN = 164 * MiB;
constexpr size_t WS_TBL = 111 * MiB + 256 * 1024;
constexpr size_t WS_BAR = 111 * MiB + 512 * 1024;
constexpr int LDS_BYTES = 147456, LDS_MISC = 131072 + 256;

DI float bf2f(bf16 b) { return __uint_as_float((unsigned)b << 16); }
typedef float f32x2_t __attribute__((ext_vector_type(2))); typedef __bf16 bf16x2_t __attribute__((ext_vector_type(2)));
DI unsigned pk2(float lo, float hi) { f32x2_t v = {lo, hi}; bf16x2_t b = __builtin_convertvector(v, bf16x2_t); return __builtin_bit_cast(unsigned, b); }
DI float fexp(float x) { return __builtin_amdgcn_exp2f(x * LOG2E); }
DI int lane_id_opaque() { unsigned m = ~0u; asm volatile("" : "+s"(m)); return (int)__builtin_amdgcn_mbcnt_hi(m, __builtin_amdgcn_mbcnt_lo(m, 0u)); }
DI float shflx(float v, int mask) { return __uint_as_float((unsigned)__builtin_amdgcn_ds_bpermute((lane_id_opaque() ^ mask) << 2, (int)__float_as_uint(v))); }
DI float xmax32(float v) { auto rr = __builtin_amdgcn_permlane32_swap(__float_as_uint(v), __float_as_uint(v), false, false); return fmaxf(__uint_as_float(rr[0]), __uint_as_float(rr[1])); }
DI float xsum32(float v) { auto rr = __builtin_amdgcn_permlane32_swap(__float_as_uint(v), __float_as_uint(v), false, false); return __uint_as_float(rr[0]) + __uint_as_float(rr[1]); }
DI float wave_sum(float v) {
#pragma unroll
    for (int o = 1; o < 64; o <<= 1) v += shflx(v, o);
    return v;
}
DI int crow(int i, int h) { return (i & 3) + 8 * (i >> 2) + 4 * h; }
#define LDS_WAIT() asm volatile("s_waitcnt lgkmcnt(0)" ::: "memory")

struct EpiF32 {
    static constexpr bool PERM = true, AFTER_DRAIN = false;
    float* O; int ldc;
    DI void operator()(const pg8::f32x4 (&acc)[2][2][4][2], const pg8::Unit& u, int wr, int wc, int fr, int fq) const {
        const int row0 = u.pm * 256 + wr * 64 + fr, col0 = u.pn * 256 + wc * 32 + 8 * fq;
#pragma unroll
        for (int ai = 0; ai < 2; ++ai)
#pragma unroll
            for (int m = 0; m < 4; ++m) { float* rowp = O + (size_t)(row0 + ai * 128 + m * 16) * ldc + col0;
#pragma unroll
                for (int bj = 0; bj < 2; ++bj) { *(f32x4*)(rowp + bj * 128) = acc[ai][bj][m][0]; *(f32x4*)(rowp + bj * 128 + 4) = acc[ai][bj][m][1]; } }
    }
};
struct EpiB16 {
    static constexpr bool PERM = true, AFTER_DRAIN = false;
    bf16* O; int ldc; float scale;
    DI void operator()(const pg8::f32x4 (&acc)[2][2][4][2], const pg8::Unit& u, int wr, int wc, int fr, int fq) const {
        const int row0 = u.pm * 256 + wr * 64 + fr, col0 = u.pn * 256 + wc * 32 + 8 * fq;
#pragma unroll
        for (int ai = 0; ai < 2; ++ai)
#pragma unroll
            for (int m = 0; m < 4; ++m) { bf16* rowp = O + (size_t)(row0 + ai * 128 + m * 16) * ldc + col0;
#pragma unroll
                for (int bj = 0; bj < 2; ++bj) { const pg8::f32x4 v0 = acc[ai][bj][m][0] * scale, v1 = acc[ai][bj][m][1] * scale;
                    u32x4 w; w.x = pk2(v0[0], v0[1]); w.y = pk2(v0[2], v0[3]); w.z = pk2(v1[0], v1[1]); w.w = pk2(v1[2], v1[3]);
                    *(u32x4*)(rowp + bj * 128) = w; } }
    }
};
struct EpiSwiGLU {
    static constexpr bool PERM = true, AFTER_DRAIN = false;
    bf16* O; int ldc;
    DI void operator()(const pg8::f32x4 (&acc)[2][2][4][2], const pg8::Unit& u, int wr, int wc, int fr, int fq) const {
        const int row0 = u.pm * 256 + wr * 64 + fr, col0 = u.pn * 128 + wc * 32 + 8 * fq;
#pragma unroll
        for (int ai = 0; ai < 2; ++ai)
#pragma unroll
            for (int m = 0; m < 4; ++m) { bf16* rowp = O + (size_t)(row0 + ai * 128 + m * 16) * ldc + col0;
                float r[8];
#pragma unroll
                for (int n = 0; n < 2; ++n)
#pragma unroll
                    for (int j = 0; j < 4; ++j) { const float gt = acc[ai][0][m][n][j], up = acc[ai][1][m][n][j]; r[n * 4 + j] = gt * up * __builtin_amdgcn_rcpf(1.f + fexp(-gt)); }
                u32x4 w; w.x = pk2(r[0], r[1]); w.y = pk2(r[2], r[3]); w.z = pk2(r[4], r[5]); w.w = pk2(r[6], r[7]);
                *(u32x4*)rowp = w; }
    }
};
struct EpiInProj {
    static constexpr bool PERM = true, AFTER_DRAIN = false;
    unsigned char* rd; const float* lb;
    DI void operator()(const pg8::f32x4 (&acc)[2][2][4][2], const pg8::Unit& u, int wr, int wc, int fr, int fq) const {
        const int seg = u.pn >> 2, row0 = u.pm * 256 + wr * 64 + fr, col0 = (u.pn & 3) * 256 + wc * 32 + 8 * fq;
        if (seg == 3) {
            float* O = (float*)(rd + RD_LOGF);
            float lbv[2][8];
#pragma unroll
            for (int bj = 0; bj < 2; ++bj)
#pragma unroll
                for (int j = 0; j < 8; ++j) lbv[bj][j] = lb[col0 + bj * 128 + j];
#pragma unroll
            for (int ai = 0; ai < 2; ++ai)
#pragma unroll
                for (int m = 0; m < 4; ++m) { float* rowp = O + (size_t)(row0 + ai * 128 + m * 16) * 1024 + col0;
#pragma unroll
                    for (int bj = 0; bj < 2; ++bj)
#pragma unroll
                        for (int n = 0; n < 2; ++n) { f32x4 o;
#pragma unroll
                            for (int j = 0; j < 4; ++j) { const float z = acc[ai][bj][m][n][j], l0 = lbv[bj][n * 4 + j];
                                const float sg = __builtin_amdgcn_rcpf(1.f + fexp(-z)); const float f = fmaxf(l0 + (1.f - l0) * sg, 1e-30f); o[j] = __logf(f); }
                            *(f32x4*)(rowp + bj * 128 + n * 4) = o; } }
        } else {
            const unsigned slot = (0x7630542u >> (4 * seg)) & 15u;
            const float sc = (seg == 0) ? 0.125f * LOG2E : 1.f;
            bf16* O = (bf16*)(rd + (size_t)slot * (32 * MiB));
#pragma unroll
            for (int ai = 0; ai < 2; ++ai)
#pragma unroll
                for (int m = 0; m < 4; ++m) { bf16* rowp = O + (size_t)(row0 + ai * 128 + m * 16) * 1024 + col0;
#pragma unroll
                    for (int bj = 0; bj < 2; ++bj) { const pg8::f32x4 v0 = acc[ai][bj][m][0] * sc, v1 = acc[ai][bj][m][1] * sc;
                        u32x4 w; w.x = pk2(v0[0], v0[1]); w.y = pk2(v0[2], v0[3]); w.z = pk2(v1[0], v1[1]); w.w = pk2(v1[2], v1[3]);
                        *(u32x4*)(rowp + bj * 128) = w; } }
        }
    }
};

template <int MODE> DI void transpose_item(const float* W, int K, int N, bf16* WT, LAS float* scr, int item, int lane) {
    const int nblk = N / 32, kb = item / nblk, nb = item % nblk, k0 = 64 * kb, n0 = 32 * nb;
    { float tmp[32]; const float* wp = W + (size_t)(k0 + (lane >> 5)) * N + n0 + (lane & 31);
#pragma unroll
      for (int i = 0; i < 32; ++i) tmp[i] = __builtin_nontemporal_load(wp + (size_t)(2 * i) * N);
#pragma unroll
      for (int i = 0; i < 32; ++i) scr[(2 * i + (lane >> 5)) * 33 + (lane & 31)] = tmp[i]; }
    LDS_WAIT(); asm volatile("" ::: "memory");
    const int c = lane & 7;
#pragma unroll
    for (int j = 0; j < 4; ++j) { const int n = (lane >> 3) + 8 * j; const LAS float* s = scr + (8 * c) * 33 + n;
        u32x4 o; o.x = pk2(s[0 * 33], s[1 * 33]); o.y = pk2(s[2 * 33], s[3 * 33]); o.z = pk2(s[4 * 33], s[5 * 33]); o.w = pk2(s[6 * 33], s[7 * 33]);
        int nn = n0 + n;
        if (MODE == 1) { if (nn < FH) nn = (nn >> 7) * 256 + (nn & 127); else { nn -= FH; nn = (nn >> 7) * 256 + 128 + (nn & 127); } }
        *(u32x4*)(WT + (size_t)nn * K + k0 + 8 * c) = o; }
    LDS_WAIT(); asm volatile("" ::: "memory");
}
DI void convert_weights(const float* const* in, int l, unsigned char* ws, LAS unsigned char* L, int gw, int NGW, int wave, int lane) {
    LAS float* scr = (LAS float*)(L + wave * 16384);
    constexpr int I_IN = 32 * (INC / 32), I_OUT = 32 * 64, I_CQ = 32 * 16, I_CKV = 32 * 32, I_CO = 8 * 64, I_FI = 32 * (2 * FH / 32), I_FO = (FH / 64) * 64;
    constexpr int NITEMS = I_IN + I_OUT + I_CQ + I_CKV + I_CO + I_FI + I_FO;
    for (int it = gw; it < NITEMS; it += NGW) {
        int r = it;
        if (r < I_IN) { transpose_item<0>(in[2] + (size_t)l * DM * INC, DM, INC, (bf16*)(ws + WS_WIN), scr, r, lane); continue; } r -= I_IN;
        if (r < I_OUT) { transpose_item<0>(in[3] + (size_t)l * DM * DM, DM, DM, (bf16*)(ws + WS_WOUT), scr, r, lane); continue; } r -= I_OUT;
        if (r < I_CQ) { transpose_item<0>(in[4] + (size_t)l * DM * CXW, DM, CXW, (bf16*)(ws + WS_WCQ), scr, r, lane); continue; } r -= I_CQ;
        if (r < I_CKV) { transpose_item<0>(in[5] + (size_t)l * DM * 1024, DM, 1024, (bf16*)(ws + WS_WCKV), scr, r, lane); continue; } r -= I_CKV;
        if (r < I_CO) { transpose_item<0>(in[6] + (size_t)l * CXW * DM, CXW, DM, (bf16*)(ws + WS_WCO), scr, r, lane); continue; } r -= I_CO;
        if (r < I_FI) { transpose_item<1>(in[7] + (size_t)l * DM * 2 * FH, DM, 2 * FH, (bf16*)(ws + WS_WFI), scr, r, lane); continue; } r -= I_FI;
        transpose_item<0>(in[8] + (size_t)l * FH * DM, FH, DM, (bf16*)(ws + WS_WFO), scr, r, lane);
    }
}

DI void norm_rows(const float* src, int nrows, const float* g, bf16* dst, int gw, int NGW, int lane) {
    int row = gw; if (row >= nrows) return;
    f32x4 v[8], vn[8];
    { const f32x4* xr = (const f32x4*)(src + (size_t)row * DM) + lane;
#pragma unroll
      for (int j = 0; j < 8; ++j) v[j] = __builtin_nontemporal_load(xr + 64 * j); }
    for (;;) {
        const int nrow = row + NGW; const bool has = nrow < nrows;
        if (has) { const f32x4* xr = (const f32x4*)(src + (size_t)nrow * DM) + lane;
#pragma unroll
            for (int j = 0; j < 8; ++j) vn[j] = __builtin_nontemporal_load(xr + 64 * j); }
        float ss = 0.f;
#pragma unroll
        for (int j = 0; j < 8; ++j) ss += (v[j].x * v[j].x + v[j].y * v[j].y) + (v[j].z * v[j].z + v[j].w * v[j].w);
        const float r = rsqrtf(wave_sum(ss) * (1.f / DM) + EPS);
        u32x2* o = (u32x2*)(dst + (size_t)row * DM) + lane;
#pragma unroll
        for (int j = 0; j < 8; ++j) { const f32x4 gg = ((const f32x4*)g)[lane + 64 * j]; u32x2 w; w.x = pk2(v[j].x * r * gg.x, v[j].y * r * gg.y); w.y = pk2(v[j].z * r * gg.z, v[j].w * r * gg.w); o[64 * j] = w; }
        if (!has) break;
#pragma unroll
        for (int j = 0; j < 8; ++j) v[j] = vn[j];
        row = nrow;
    }
}
DI void resnorm_rows(const float* Y, const float* Xs, float* Xd, const float* gpost, const float* gpre, bf16* H, int gw, int NGW, int lane) {
    int row = gw; if (row >= T) return;
    f32x4 y[8], x[8], yn[8], xn[8];
    { const f32x4* yr = (const f32x4*)(Y + (size_t)row * DM) + lane; const f32x4* xr = (const f32x4*)(Xs + (size_t)row * DM) + lane;
#pragma unroll
      for (int j = 0; j < 8; ++j) { y[j] = __builtin_nontemporal_load(yr + 64 * j); x[j] = __builtin_nontemporal_load(xr + 64 * j); } }
    for (;;) {
        const int nrow = row + NGW; const bool has = nrow < T;
        if (has) { const f32x4* yr = (const f32x4*)(Y + (size_t)nrow * DM) + lane; const f32x4* xr = (const f32x4*)(Xs + (size_t)nrow * DM) + lane;
#pragma unroll
            for (int j = 0; j < 8; ++j) { yn[j] = __builtin_nontemporal_load(yr + 64 * j); xn[j] = __builtin_nontemporal_load(xr + 64 * j); } }
        float ss = 0.f;
#pragma unroll
        for (int j = 0; j < 8; ++j) ss += (y[j].x * y[j].x + y[j].y * y[j].y) + (y[j].z * y[j].z + y[j].w * y[j].w);
        const float r = rsqrtf(wave_sum(ss) * (1.f / DM) + EPS);
        f32x4* xo = (f32x4*)(Xd + (size_t)row * DM) + lane; float s2 = 0.f;
#pragma unroll
        for (int j = 0; j < 8; ++j) { const f32x4 gg = ((const f32x4*)gpost)[lane + 64 * j]; x[j] = x[j] + y[j] * r * gg; __builtin_nontemporal_store(x[j], xo + 64 * j);
            s2 += (x[j].x * x[j].x + x[j].y * x[j].y) + (x[j].z * x[j].z + x[j].w * x[j].w); }
        if (H) {
            const float r2 = rsqrtf(wave_sum(s2) * (1.f / DM) + EPS);
            u32x2* o = (u32x2*)(H + (size_t)row * DM) + lane;
#pragma unroll
            for (int j = 0; j < 8; ++j) { const f32x4 gg = ((const f32x4*)gpre)[lane + 64 * j]; u32x2 w; w.x = pk2(x[j].x * r2 * gg.x, x[j].y * r2 * gg.y); w.y = pk2(x[j].z * r2 * gg.z, x[j].w * r2 * gg.w); o[64 * j] = w; }
        }
        if (!has) break;
#pragma unroll
        for (int j = 0; j < 8; ++j) { y[j] = yn[j]; x[j] = xn[j]; }
        row = nrow;
    }
}

DI void hg_state_units(LAS unsigned char* L, int u0, int G, const float* LOGF, const bf16* IHG, bf16* ST, float* DEC, int tid, int wave, int lane) {
    LAS bf16* KhT = (LAS bf16*)L;
    LAS bf16* Vs = (LAS bf16*)(L + 18432);
    LAS float* segtot = (LAS float*)(L + 38912);
    const int c = tid & 127, seg = tid >> 7;
    int unit = u0; if (unit >= 2048) return;
    float g[16]; bf16x8 v8[2];
#define HGS_LOAD(u_) do { const int bh_ = (u_) >> 6, n_ = (u_) & 63; const size_t tk_ = (size_t)(bh_ >> 3) * SEQ + n_ * 64; const int hc_ = (bh_ & 7) * 128; \
        _Pragma("unroll") for (int i = 0; i < 16; ++i) g[i] = LOGF[(tk_ + 16 * seg + i) * 1024 + hc_ + c]; \
        _Pragma("unroll") for (int i = 0; i < 2; ++i) { const int cid = tid + 512 * i, kv = cid >> 4, dvs = (cid & 15) * 8; v8[i] = *(const bf16x8*)(IHG + (tk_ + kv) * 1024 + hc_ + dvs); } } while (0)
    HGS_LOAD(unit);
    for (;;) {
        float tot = 0.f;
#pragma unroll
        for (int i = 0; i < 16; ++i) tot += g[i];
        segtot[seg * 128 + c] = tot;
#pragma unroll
        for (int i = 0; i < 2; ++i) { const int cid = tid + 512 * i, kv = cid >> 4, dvs = (cid & 15) * 8; *(LAS bf16x8*)(Vs + kv * 160 + dvs) = v8[i]; }
        __syncthreads();
        float off = 0.f, total = 0.f;
#pragma unroll
        for (int s = 0; s < 4; ++s) { const float t_ = segtot[s * 128 + c]; if (s < seg) off += t_; total += t_; }
        float run = off; float kh[16];
#pragma unroll
        for (int i = 0; i < 16; ++i) { run += g[i]; kh[i] = (1.f - fexp(g[i])) * fexp(total - run); }
        { u32x4 w0, w1; w0.x = pk2(kh[0], kh[1]); w0.y = pk2(kh[2], kh[3]); w0.z = pk2(kh[4], kh[5]); w0.w = pk2(kh[6], kh[7]);
          w1.x = pk2(kh[8], kh[9]); w1.y = pk2(kh[10], kh[11]); w1.z = pk2(kh[12], kh[13]); w1.w = pk2(kh[14], kh[15]);
          *(LAS u32x4*)(KhT + c * 72 + 16 * seg) = w0; *(LAS u32x4*)(KhT + c * 72 + 16 * seg + 8) = w1; }
        if (seg == 0) DEC[(size_t)unit * 128 + c] = fexp(total);
        const int nunit = unit + G; const bool has = nunit < 2048;
        if (has) HGS_LOAD(nunit);
        __syncthreads();
        const int lr = lane & 15, quad = lane >> 4;
        bf16x8 bfr[2];
#pragma unroll
        for (int ks = 0; ks < 2; ++ks) { const LAS bf16* vp = Vs + (32 * ks + quad * 8 + (lr >> 2)) * 160 + 16 * wave + 4 * (lr & 3);
            const s16x4 lo = __builtin_bit_cast(s16x4, __builtin_amdgcn_ds_read_tr16_b64_v4i16((LAS v4i16_t*)vp)), hi = __builtin_bit_cast(s16x4, __builtin_amdgcn_ds_read_tr16_b64_v4i16((LAS v4i16_t*)(vp + 4 * 160)));
            bfr[ks] = __builtin_shufflevector(lo, hi, 0, 1, 2, 3, 4, 5, 6, 7); }
        bf16* dst = ST + (size_t)unit * 16384 + (size_t)(16 * wave + lr) * 128 + quad * 4;
#pragma unroll
        for (int ct = 0; ct < 8; ++ct) {
            pg8::f32x4 acc = {0.f, 0.f, 0.f, 0.f};
#pragma unroll
            for (int ks = 0; ks < 2; ++ks) { const bf16x8 a = *(const LAS bf16x8*)(KhT + (16 * ct + lr) * 72 + 32 * ks + quad * 8); acc = __builtin_amdgcn_mfma_f32_16x16x32_bf16(a, bfr[ks], acc, 0, 0, 0); }
            u32x2 w; w.x = pk2(acc[0], acc[1]); w.y = pk2(acc[2], acc[3]); *(u32x2*)(dst + 16 * ct) = w;
        }
        __syncthreads();
        if (!has) break;
        unit = nunit;
    }
#undef HGS_LOAD
}
DI void hg_scan(bf16* ST, const float* DEC, int gtid, int NTH) {
    for (int e = gtid; e < 32 * 4096; e += NTH) {
        const int bh = e >> 12, rem = e & 4095, dv = rem >> 5, c = (rem & 31) * 4;
        f32x4 S = {0.f, 0.f, 0.f, 0.f};
        bf16* p = ST + (size_t)bh * 64 * 16384 + dv * 128 + c; const float* dp = DEC + (size_t)bh * 64 * 128 + c;
#pragma unroll 8
        for (int n = 0; n < 64; ++n) {
            const u32x2 u = *(const u32x2*)(p + (size_t)n * 16384); const f32x4 d = *(const f32x4*)(dp + n * 128);
            u32x2 w; w.x = pk2(S.x, S.y); w.y = pk2(S.z, S.w); *(u32x2*)(p + (size_t)n * 16384) = w;
            f32x4 uf; uf.x = __uint_as_float(u.x << 16); uf.y = __uint_as_float(u.x & 0xffff0000u); uf.z = __uint_as_float(u.y << 16); uf.w = __uint_as_float(u.y & 0xffff0000u);
            S = d * S + uf;
        }
    }
}
DI void hg_out_units(LAS unsigned char* L, int u0, int G, const float* LOGF, const bf16* QHG, const bf16* IHG, const bf16* GHG, const bf16* ST, const float* og, bf16* MIX, int tid, int wave, int lane) {
    LAS bf16* Qt = (LAS bf16*)L;
    LAS bf16* Kt = (LAS bf16*)(L + 17408);
    LAS bf16* Qh = (LAS bf16*)(L + 34816);
    LAS bf16* Vs = (LAS bf16*)(L + 52224);
    LAS bf16* At = (LAS bf16*)(L + 72704);
    LAS float* segtot = (LAS float*)(L + 81920);
    LAS float* ssq = (LAS float*)(L + 83968);
    const int c = tid & 127, seg = tid >> 7;
    const int lr = lane & 15, quad = lane >> 4, tt = wave >> 1, dh = wave & 1;
    int unit = u0; if (unit >= 2048) return;
    float g[16]; bf16 qraw[16]; bf16x8 v8[2];
#define HGO_LOAD(u_) do { const int bh_ = (u_) >> 6, n_ = (u_) & 63; const size_t tk_ = (size_t)(bh_ >> 3) * SEQ + n_ * 64; const int hc_ = (bh_ & 7) * 128; \
        _Pragma("unroll") for (int i = 0; i < 16; ++i) { g[i] = LOGF[(tk_ + 16 * seg + i) * 1024 + hc_ + c]; qraw[i] = QHG[(tk_ + 16 * seg + i) * 1024 + hc_ + c]; } \
        _Pragma("unroll") for (int i = 0; i < 2; ++i) { const int cid = tid + 512 * i, kv = cid >> 4, dvs = (cid & 15) * 8; v8[i] = *(const bf16x8*)(IHG + (tk_ + kv) * 1024 + hc_ + dvs); } } while (0)
    HGO_LOAD(unit);
    for (;;) {
    const int bh = unit >> 6, n = unit & 63, b_ = bh >> 3, h = bh & 7; const size_t tok0 = (size_t)b_ * SEQ + n * 64;
    const bf16* stp = ST + (size_t)unit * 16384;
    bf16x8 stf[4][4]; u32x2 gtv[4];
#pragma unroll
    for (int d = 0; d < 4; ++d) { const int dt = 4 * dh + d;
#pragma unroll
        for (int ks = 0; ks < 4; ++ks) stf[d][ks] = *(const bf16x8*)(stp + (size_t)(16 * dt + lr) * 128 + 32 * ks + quad * 8);
        gtv[d] = *(const u32x2*)(GHG + (tok0 + 16 * tt + lr) * 1024 + h * 128 + 16 * dt + quad * 4); }
    float tot = 0.f;
#pragma unroll
    for (int i = 0; i < 16; ++i) tot += g[i];
    segtot[seg * 128 + c] = tot;
#pragma unroll
    for (int i = 0; i < 2; ++i) { const int cid = tid + 512 * i, kv = cid >> 4, dvs = (cid & 15) * 8; *(LAS bf16x8*)(Vs + kv * 160 + dvs) = v8[i]; }
    __syncthreads();
    float off = 0.f;
#pragma unroll
    for (int s = 0; s < 4; ++s) { const float t_ = segtot[s * 128 + c]; if (s < seg) off += t_; }
    const float bmid = segtot[c] + segtot[128 + c];
    float run = off;
#pragma unroll
    for (int i = 0; i < 16; ++i) { const int s = 16 * seg + i; run += g[i];
        const float qv = bf2f(qraw[i]); const float kk = 1.f - fexp(g[i]);
        Qt[s * 136 + c] = (bf16)(pk2(qv * fexp(run - bmid), 0.f) & 0xffffu);
        Kt[s * 136 + c] = (bf16)(pk2(kk * fexp(bmid - run), 0.f) & 0xffffu);
        Qh[s * 136 + c] = (bf16)(pk2(qv * fexp(run), 0.f) & 0xffffu); }
    const int nunit = unit + G; const bool has = nunit < 2048;
    if (has) HGO_LOAD(nunit);
    __syncthreads();
#pragma unroll
    for (int e = 0; e < 2; ++e) { const int id = 2 * wave + e, tt = id >> 2, st = id & 3;
        pg8::f32x4 acc = {0.f, 0.f, 0.f, 0.f};
        if (st <= tt) {
#pragma unroll
            for (int ks = 0; ks < 4; ++ks) { const bf16x8 a = *(const LAS bf16x8*)(Kt + (16 * st + lr) * 136 + 32 * ks + quad * 8); const bf16x8 b = *(const LAS bf16x8*)(Qt + (16 * tt + lr) * 136 + 32 * ks + quad * 8);
                acc = __builtin_amdgcn_mfma_f32_16x16x32_bf16(a, b, acc, 0, 0, 0); }
            const int tpos = 16 * tt + lr, s0 = 16 * st + quad * 4;
#pragma unroll
            for (int j = 0; j < 4; ++j) acc[j] = (s0 + j <= tpos) ? acc[j] : 0.f;
        }
        u32x2 w; w.x = pk2(acc[0], acc[1]); w.y = pk2(acc[2], acc[3]); *(LAS u32x2*)(At + (16 * tt + lr) * 72 + 16 * st + quad * 4) = w; }
    __syncthreads();
    pg8::f32x4 acc[4];
    bf16x8 bA[2], bQ[4];
#pragma unroll
    for (int ks = 0; ks < 2; ++ks) bA[ks] = *(const LAS bf16x8*)(At + (16 * tt + lr) * 72 + 32 * ks + quad * 8);
#pragma unroll
    for (int ks = 0; ks < 4; ++ks) bQ[ks] = *(const LAS bf16x8*)(Qh + (16 * tt + lr) * 136 + 32 * ks + quad * 8);
    float ss = 0.f;
#pragma unroll
    for (int d = 0; d < 4; ++d) { const int dt = 4 * dh + d; acc[d] = (pg8::f32x4){0.f, 0.f, 0.f, 0.f};
#pragma unroll
        for (int ks = 0; ks < 2; ++ks) { const LAS bf16* vp = Vs + (32 * ks + quad * 8 + (lr >> 2)) * 160 + 16 * dt + 4 * (lr & 3);
            const s16x4 lo = __builtin_bit_cast(s16x4, __builtin_amdgcn_ds_read_tr16_b64_v4i16((LAS v4i16_t*)vp)), hi = __builtin_bit_cast(s16x4, __builtin_amdgcn_ds_read_tr16_b64_v4i16((LAS v4i16_t*)(vp + 4 * 160)));
            const bf16x8 a = __builtin_shufflevector(lo, hi, 0, 1, 2, 3, 4, 5, 6, 7); acc[d] = __builtin_amdgcn_mfma_f32_16x16x32_bf16(a, bA[ks], acc[d], 0, 0, 0); }
#pragma unroll
        for (int ks = 0; ks < 4; ++ks) acc[d] = __builtin_amdgcn_mfma_f32_16x16x32_bf16(stf[d][ks], bQ[ks], acc[d], 0, 0, 0);
        ss += (acc[d][0] * acc[d][0] + acc[d][1] * acc[d][1]) + (acc[d][2] * acc[d][2] + acc[d][3] * acc[d][3]); }
    ss += shflx(ss, 16); ss += shflx(ss, 32);
    if (quad == 0) ssq[(16 * tt + lr) * 2 + dh] = ss;
    __syncthreads();
    const float r = rsqrtf((ssq[(16 * tt + lr) * 2] + ssq[(16 * tt + lr) * 2 + 1]) * (1.f / 128.f) + EPS);
    const size_t tok = tok0 + 16 * tt + lr;
#pragma unroll
    for (int d = 0; d < 4; ++d) { const int dv0 = 16 * (4 * dh + d) + quad * 4;
        const u32x2 gt = gtv[d]; const f32x4 gn = *(const f32x4*)(og + dv0);
        float gv[4] = {__uint_as_float(gt.x << 16), __uint_as_float(gt.x & 0xffff0000u), __uint_as_float(gt.y << 16), __uint_as_float(gt.y & 0xffff0000u)};
        float o[4];
#pragma unroll
        for (int j = 0; j < 4; ++j) o[j] = acc[d][j] * r * gn[j] * gv[j] * __builtin_amdgcn_rcpf(1.f + fexp(-gv[j]));
        u32x2 w; w.x = pk2(o[0], o[1]); w.y = pk2(o[2], o[3]); *(u32x2*)(MIX + tok * DM + 1024 + h * 128 + dv0) = w; }
    __syncthreads();
    if (!has) break;
    unit = nunit;
    }
#undef HGO_LOAD
}

constexpr int ATT_KP = 136, ATT_VP = 160, ATT_KSLOT = 64 * ATT_KP * 2, ATT_VSLOT = 64 * ATT_VP * 2;
template <bool DIFF, int ND0> DI void att_qk_softmax(const LAS unsigned char* Kc, const bf16x8 (&qf)[ND0], const LAS float* tbl, int t, int qbase, int r, int h_, bool act1,
                                                      float& m_run, float& l_run, f32x16& negm, f32x16 (&y)[4], bf16x8 (&pf)[2][2]) {
    f32x16 p[2];
#pragma unroll
    for (int sub = 0; sub < 2; ++sub) {
        p[sub] = negm;
        if (sub == 0 || act1) {
#pragma unroll
            for (int d0 = 0; d0 < ND0; ++d0) { const bf16x8 kf = *(const LAS bf16x8*)(Kc + (32 * sub * ATT_KP + 16 * d0) * 2);
                p[sub] = __builtin_amdgcn_mfma_f32_32x32x16_bf16(kf, qf[d0], p[sub], 0, 0, 0); }
        }
    }
    const bool far = !DIFF || (qbase - (64 * t + 63) >= 128);
    if (!far) {
        const int qpos = qbase + r;
#pragma unroll
        for (int sub = 0; sub < 2; ++sub)
#pragma unroll
            for (int i = 0; i < 16; ++i) p[sub][i] += tbl[qpos + 96 - (64 * t + 32 * sub + crow(i, h_))];
    }
    float mx = -INFINITY;
#pragma unroll
    for (int sub = 0; sub < 2; ++sub)
#pragma unroll
        for (int i = 0; i < 16; ++i) mx = fmaxf(mx, p[sub][i]);
    mx = xmax32(mx);
    if (t == 0 || __any(mx > 8.f)) {
        const float dl = (t == 0) ? mx : fmaxf(mx, 0.f), alpha = __builtin_amdgcn_exp2f(-dl);
        m_run += dl; l_run *= alpha;
#pragma unroll
        for (int i = 0; i < 16; ++i) { negm[i] = -m_run; p[0][i] -= dl; p[1][i] -= dl; }
#pragma unroll
        for (int d0 = 0; d0 < 4; ++d0)
#pragma unroll
            for (int i = 0; i < 16; ++i) y[d0][i] *= alpha;
    }
    float rs = 0.f;
#pragma unroll
    for (int sub = 0; sub < 2; ++sub)
#pragma unroll
        for (int i = 0; i < 16; ++i) { const float e = __builtin_amdgcn_exp2f(p[sub][i]); p[sub][i] = e; rs += e; }
    l_run += rs;
#pragma unroll
    for (int sub = 0; sub < 2; ++sub)
#pragma unroll
        for (int s = 0; s < 2; ++s) { u32x4 pw; pw.x = pk2(p[sub][8 * s], p[sub][8 * s + 1]); pw.y = pk2(p[sub][8 * s + 2], p[sub][8 * s + 3]); pw.z = pk2(p[sub][8 * s + 4], p[sub][8 * s + 5]); pw.w = pk2(p[sub][8 * s + 6], p[sub][8 * s + 7]);
            pf[sub][s] = __builtin_bit_cast(bf16x8, pw); }
}
DI void att_pv(const LAS unsigned char* Vc, const bf16x8 (&pf)[2][2], f32x16 (&y)[4], bool act1) {
#pragma unroll
    for (int sub = 0; sub < 2; ++sub) {
        if (sub == 0 || act1) {
#pragma unroll
            for (int s = 0; s < 2; ++s) {
            __builtin_amdgcn_sched_barrier(0);
#pragma unroll
                for (int d0 = 0; d0 < 4; ++d0) { const LAS unsigned char* vp = Vc + ((32 * sub + 16 * s) * ATT_VP + 32 * d0) * 2;
                    const s16x4 lo = __builtin_bit_cast(s16x4, __builtin_amdgcn_ds_read_tr16_b64_v4i16((LAS v4i16_t*)vp));
                    const s16x4 hi = __builtin_bit_cast(s16x4, __builtin_amdgcn_ds_read_tr16_b64_v4i16((LAS v4i16_t*)(vp + 8 * ATT_VP * 2)));
                    const bf16x8 vf = __builtin_shufflevector(lo, hi, 0, 1, 2, 3, 4, 5, 6, 7);
                    y[d0] = __builtin_amdgcn_mfma_f32_32x32x16_bf16(vf, pf[sub][s], y[d0], 0, 0, 0); }
            }
        }
    }
    __builtin_amdgcn_sched_barrier(0);
}
template <bool DIFF> DI void attn_unit(LAS unsigned char* L, const bf16* Qh, int qpitch, const bf16* Kh, const bf16* Vh, int kvpitch, bf16* Oh, int opitch,
                                       size_t qrow0, int qpos0, size_t kvrow0, int NT, const float* relb_h  , float lam, float postscale, const float* subg,
                                       int tid, int wave, int lane) {
    constexpr int ND0 = DIFF ? 4 : 8;
    constexpr int KP = ATT_KP, VP = ATT_VP, KSLOT = ATT_KSLOT, VSLOT = ATT_VSLOT;
    LAS float* tbl = (LAS float*)(L + 2 * KSLOT + 3 * VSLOT);
    LAS float* exch = (LAS float*)L;
    const int r = lane & 31, h_ = lane >> 5, g_ = (lane >> 4) & 1, q_ = (lane & 15) >> 2, p_ = lane & 3;
    const int wq0 = DIFF ? (wave >> 1) * 32 : wave * 32, kcol = DIFF ? (wave & 1) * 64 : 0;
    const bool stag = wave >= 4;
    bf16x8 qf[ND0];
    { const bf16* qp = Qh + (qrow0 + wq0 + r) * (size_t)qpitch + kcol + 8 * h_;
#pragma unroll
      for (int d0 = 0; d0 < ND0; ++d0) qf[d0] = *(const bf16x8*)(qp + 16 * d0); }
    f32x16 y[4];
#pragma unroll
    for (int d0 = 0; d0 < 4; ++d0)
#pragma unroll
        for (int i = 0; i < 16; ++i) y[d0][i] = 0.f;
    float m_run = 0.f, l_run = 0.f;
    f32x16 negm;
#pragma unroll
    for (int i = 0; i < 16; ++i) negm[i] = 0.f;
    bf16x8 kreg[2], vreg[2];
    const int skv0 = tid >> 4, scol = (tid & 15) * 8;
    const int loff = skv0 * kvpitch + scol;
#define ATT_LOAD(t) do { const int tw_ = DIFF ? (t) : ((t) & 3); const bf16* Kt_ = Kh + (kvrow0 + (size_t)tw_ * 64) * kvpitch; const bf16* Vt_ = Vh + (kvrow0 + (size_t)tw_ * 64) * kvpitch; \
        _Pragma("unroll") for (int i_ = 0; i_ < 2; ++i_) { kreg[i_] = *(const bf16x8*)(Kt_ + loff + 32 * i_ * kvpitch); vreg[i_] = *(const bf16x8*)(Vt_ + loff + 32 * i_ * kvpitch); } } while (0)
#define ATT_STORE(ks, vs) do { _Pragma("unroll") for (int i_ = 0; i_ < 2; ++i_) { const int kv_ = skv0 + 32 * i_; \
        *(LAS bf16x8*)(L + (ks) * KSLOT + (kv_ * KP + scol) * 2) = kreg[i_]; *(LAS bf16x8*)(L + 2 * KSLOT + (vs) * VSLOT + (kv_ * VP + scol) * 2) = vreg[i_]; } } while (0)
    ATT_LOAD(0);
    float tb_ = -INFINITY; if (DIFF && tid >= 96 && tid < 352) tb_ = relb_h[tid - 96];
    ATT_STORE(0, 0);
    if (NT > 1) ATT_LOAD(1);
    if (DIFF && tid < 352) tbl[tid] = tb_;
    __syncthreads();
    const int koff = ((r * KP) + kcol + 8 * h_) * 2;
    const int voff = 2 * KSLOT + ((4 * h_ + q_) * VP + 16 * g_ + 4 * p_) * 2;
    bf16x8 pf[2][2]; bool pa0 = false, pa1 = false;
#pragma unroll
    for (int a = 0; a < 2; ++a)
#pragma unroll
        for (int b = 0; b < 2; ++b) pf[a][b] = (bf16x8){0, 0, 0, 0, 0, 0, 0, 0};
    int vcur = 0, vprev = 2;
    const int qbase = qpos0 + wq0, qlast = qbase + 31;
    for (int t = 0; t < NT; ++t) {
        const int cur = t & 1, vnext = (vcur == 2) ? 0 : vcur + 1;
        if (t + 1 < NT) ATT_STORE(cur ^ 1, vnext);
        if (t + 2 < NT) ATT_LOAD(t + 2);
        const LAS unsigned char* Kc = L + cur * KSLOT + koff;
        const bool act0 = !DIFF || (64 * t <= qlast), act1 = !DIFF || (64 * t + 32 <= qlast);
        if (stag && pa0) att_pv(L + voff + vprev * VSLOT, pf, y, pa1);
        if (act0) att_qk_softmax<DIFF, ND0>(Kc, qf, tbl, t, qbase, r, h_, act1, m_run, l_run, negm, y, pf);
        if (!stag && act0) att_pv(L + voff + vcur * VSLOT, pf, y, act1);
        pa0 = act0; pa1 = act1;
        vprev = vcur; vcur = vnext;
        __syncthreads();
    }
    if (stag && pa0) att_pv(L + voff + vprev * VSLOT, pf, y, pa1);
    __syncthreads();
#undef ATT_LOAD
#undef ATT_STORE
    const float inv = 1.f / xsum32(l_run);
    int le_ = lane; asm volatile("" : "+v"(le_));
    const int r_e = le_ & 31, h_e = le_ >> 5;
    bf16* orow = Oh + (qrow0 + wq0 + r_e) * (size_t)opitch;
    if (DIFF) {
        const int qs = wave >> 1, mp = wave & 1;
        if (mp == 1) {
#pragma unroll
            for (int d0 = 0; d0 < 4; ++d0)
#pragma unroll
                for (int i = 0; i < 16; ++i) exch[((qs * 4 + d0) * 16 + i) * 64 + le_] = y[d0][i] * inv;
        }
        __syncthreads();
        if (mp == 0) {
            float ss = 0.f;
#pragma unroll
            for (int d0 = 0; d0 < 4; ++d0)
#pragma unroll
                for (int i = 0; i < 16; ++i) { const float o = y[d0][i] * inv - lam * exch[((qs * 4 + d0) * 16 + i) * 64 + le_]; y[d0][i] = o; ss += o * o; }
            ss += shflx(ss, 32);
            const float rr = rsqrtf(ss * (1.f / 128.f) + EPS) * postscale;
#pragma unroll
            for (int d0 = 0; d0 < 4; ++d0)
#pragma unroll
                for (int g = 0; g < 4; ++g) { const int dv0 = 32 * d0 + 8 * g + 4 * h_e; const f32x4 sg = *(const f32x4*)(subg + dv0);
                    u32x2 w; w.x = pk2(y[d0][4 * g] * rr * sg.x, y[d0][4 * g + 1] * rr * sg.y); w.y = pk2(y[d0][4 * g + 2] * rr * sg.z, y[d0][4 * g + 3] * rr * sg.w);
                    *(u32x2*)(orow + dv0) = w; }
        }
    } else {
#pragma unroll
        for (int d0 = 0; d0 < 4; ++d0)
#pragma unroll
            for (int g = 0; g < 4; ++g) { const int dv0 = 32 * d0 + 8 * g + 4 * h_e;
                u32x2 w; w.x = pk2(y[d0][4 * g] * inv, y[d0][4 * g + 1] * inv); w.y = pk2(y[d0][4 * g + 2] * inv, y[d0][4 * g + 3] * inv);
                *(u32x2*)(orow + dv0) = w; }
    }
    __syncthreads();
}

#define XB_TMO      128
#define XB_XCNT(j)  (256  + 64 * (j))
#define XB_XSUB(j)  (1280 + 64 * (j))
#define XB_XGEN(j)  (2304 + 64 * (j))
#define XB_TOP      3328
#define XB_TOPGEN   3392
#define XCD_BAR_WORDS 3456
#define XB_SPIN_CAP (1u << 18)

__device__ __forceinline__ unsigned xb_ld(unsigned* p)              { return __hip_atomic_load(p, __ATOMIC_RELAXED, __HIP_MEMORY_SCOPE_AGENT); }
__device__ __forceinline__ unsigned xb_add(unsigned* p, unsigned v) { return __hip_atomic_fetch_add(p, v, __ATOMIC_RELAXED, __HIP_MEMORY_SCOPE_AGENT); }
__device__ __forceinline__ unsigned xb_xcc_id() { return (unsigned)__builtin_amdgcn_s_getreg((3 << 11) | 20) & 0xFu; }
#define XB_SPIN(cond, bar) do { unsigned _sp = 0; while (cond) { __builtin_amdgcn_s_sleep(1); \
    if ((++_sp & 255u) == 0u) { if (xb_ld(&(bar)[XB_TMO])) break; if (_sp > XB_SPIN_CAP) { atomicAdd(&(bar)[XB_TMO], 1u); break; } } } } while (0)

struct XcdBarrier {
    unsigned* bar; unsigned x;
    volatile LAS unsigned* st;
};

__device__ __forceinline__ XcdBarrier xcd_barrier_post(unsigned* bar, volatile LAS unsigned* st, int xtid) {
    XcdBarrier b; b.bar = bar; b.x = xb_xcc_id(); b.st = st;
    if (xtid == 0) (void)xb_add(&bar[XB_XCNT(b.x)], 1u);
    return b;
}
__device__ __forceinline__ void xcd_barrier_complete(unsigned* bar, unsigned x, unsigned& nloc, unsigned& nx) {
    const unsigned G = gridDim.x * gridDim.y * gridDim.z;
    unsigned sum, cnt, mine, sp = 0u;
    for (;;) {
        sum = 0u; cnt = 0u; mine = 0u;
#pragma unroll
        for (unsigned j = 0; j < 16; ++j) { const unsigned c = xb_ld(&bar[XB_XCNT(j)]); sum += c; cnt += (c > 0u) ? 1u : 0u; mine = (j == x) ? c : mine; }
        if (sum == G) break;
        __builtin_amdgcn_s_sleep(1);
        if ((++sp & 255u) == 0u) { if (xb_ld(&bar[XB_TMO])) break; if (sp > XB_SPIN_CAP) { atomicAdd(&bar[XB_TMO], 1u); break; } }
    }
    nloc = mine > 0u ? mine : 1u; nx = cnt > 0u ? cnt : 1u;
}

__device__ __forceinline__ void xcd_barrier(const XcdBarrier& b, int xtid) {
    asm volatile("s_waitcnt vmcnt(0)" ::: "memory");
    __syncthreads();
    if (xtid == 0) {
        unsigned* bar = b.bar;
        __builtin_amdgcn_s_waitcnt(0);
        unsigned nloc = b.st[0], nx = b.st[1];
        if (nloc == 0u) { xcd_barrier_complete(bar, b.x, nloc, nx); b.st[0] = nloc; b.st[1] = nx; }
        const unsigned old = xb_add(&bar[XB_XSUB(b.x)], 1u);
        const unsigned gen = old / nloc;
        if (old + 1u == (gen + 1u) * nloc) {
            __builtin_amdgcn_fence(__ATOMIC_RELEASE, "agent");
            asm volatile("s_waitcnt vmcnt(0)" ::: "memory");
            const unsigned og = xb_add(&bar[XB_TOP], 1u);
            const unsigned tg = og / nx;
            if (og + 1u == (tg + 1u) * nx) xb_add(&bar[XB_TOPGEN], 1u);
            else XB_SPIN(xb_ld(&bar[XB_TOPGEN]) == tg, bar);
            __builtin_amdgcn_fence(__ATOMIC_ACQUIRE, "agent");
            xb_add(&bar[XB_XGEN(b.x)], 1u);
            asm volatile("s_waitcnt vmcnt(0)" ::: "memory");
        } else {
            XB_SPIN(xb_ld(&bar[XB_XGEN(b.x)]) == gen, bar);
            __builtin_amdgcn_fence(__ATOMIC_ACQUIRE, "agent");
            asm volatile("s_waitcnt vmcnt(0)" ::: "memory");
        }
    }
    __syncthreads();
}

struct Params { const float* in[24]; float* out; unsigned char* ws; };


template <class Epi> DI void run_gemm(LAS unsigned char* L, int tid, const bf16* A, const bf16* Bt, int M, int N, int K, const Epi& E, int shift = 0) {
    pg8::Gemm g{A, Bt, M, N, K}; pg8::StaticOrder S; S.init(M, N, (int)gridDim.x, (int)((blockIdx.x + shift) % gridDim.x));
    pg8::gemm_phase<Epi, pg8::StaticOrder, true, true>(L, g, S, E, tid);
}

__global__ void __launch_bounds__(512, 2) mega_fwd(Params P) {
    extern __shared__ __attribute__((aligned(16))) unsigned char lds_raw[];
    LAS unsigned char* L = (LAS unsigned char*)lds_raw;
    cg::grid_group grid = cg::this_grid();
    const int G = gridDim.x, bid = blockIdx.x, NGW = G * 8, NTH = G * 512;
    const int wave0 = __builtin_amdgcn_readfirstlane((int)(threadIdx.x >> 6));
#define TIDX() (wave0 * 64 + lane_id_opaque())
#define PH_BEGIN() int tid = wave0 * 64 + lane_id_opaque(); long zoff_ = 0; asm volatile("" : "+v"(tid), "+s"(zoff_)); unsigned char* ws = P.ws + zoff_; \
    const int lane = tid & 63, wave = __builtin_amdgcn_readfirstlane(tid >> 6), gw = bid * 8 + wave, gtid = bid * 512 + tid; unsigned char* rd = ws + WS_RD; \
    (void)lane; (void)wave; (void)gw; (void)gtid; (void)rd;
#define X (P.out)
    volatile LAS unsigned* MISC = (volatile LAS unsigned*)(L + LDS_MISC);
    { const int t0 = TIDX(); if (t0 < 2) MISC[t0] = 0u;
      unsigned* barw = (unsigned*)(P.ws + WS_BAR);
      if (bid == 0) for (int i = t0; i < XCD_BAR_WORDS; i += 512) barw[i] = 0u; }
    __syncthreads();
#define GRID_SYNC() do { asm volatile("s_waitcnt vmcnt(0) lgkmcnt(0)" ::: "memory"); grid.sync(); } while (0)
#define XSYNC() do { XcdBarrier xb_; xb_.bar = (unsigned*)(P.ws + WS_BAR); xb_.x = xb_xcc_id(); xb_.st = (volatile LAS unsigned*)(L + LDS_MISC); xcd_barrier(xb_, TIDX()); } while (0)

    { PH_BEGIN();
      convert_weights(P.in, 0, ws, L, gw, NGW, wave, lane);
      float* LB = (float*)(ws + WS_LB);
      { float* TBL = (float*)(ws + WS_TBL);
        for (int i = gtid; i < 2048; i += NTH) { const int hh = i >> 8, nn = i & 255; int bk;
            if (nn < 16) bk = nn; else { bk = 16 + (int)(__logf((float)nn * (1.f / 16.f)) / 2.0794415416798357f * 16.f); bk = bk > 31 ? 31 : bk; }
            TBL[i] = (P.in[23][bk * 8 + hh] - P.in[23][31 * 8 + hh]) * LOG2E; } }
      for (int i = gtid; i < 2048; i += NTH) { const int c = i & 1023; LB[i] = (i < 1024) ? 0.f : 1.f / (1.f + fexp(P.in[22][c] - P.in[22][1024 + c])); }
      norm_rows(P.in[0], T, P.in[9], (bf16*)(ws + WS_H), gw, NGW, lane); }
    GRID_SYNC();
    (void)xcd_barrier_post((unsigned*)(P.ws + WS_BAR), (volatile LAS unsigned*)(L + LDS_MISC), TIDX());

    for (int l = 0; l < 2; ++l) {
        { PH_BEGIN(); EpiInProj E{rd, (const float*)(ws + WS_LB) + l * 1024}; run_gemm(L, tid, (const bf16*)(ws + WS_H), (const bf16*)(ws + WS_WIN), T, INC, DM, E); }
        XSYNC();
        { PH_BEGIN();
          hg_state_units(L, bid, G, (const float*)(rd + RD_LOGF), (const bf16*)(rd + RD_IHG), (bf16*)(ws + WS_H), (float*)(ws + WS_DEC), tid, wave, lane); }
        { PH_BEGIN();
            const float lam_init = (l == 0) ? 0.2f : (0.8f - 0.6f * 0.7408182206817179f);
            const float a1 = wave_sum(P.in[18][l * 64 + lane] * P.in[19][l * 64 + lane]), a2 = wave_sum(P.in[20][l * 64 + lane] * P.in[21][l * 64 + lane]);
            const float lam = __uint_as_float(__builtin_amdgcn_readfirstlane(__float_as_uint(fexp(a1) - fexp(a2) + lam_init)));
            const int vcu = (G == 256) ? (((bid & 7) << 5) | (bid >> 3)) : bid;
            for (int sidx = vcu; sidx < 1024; sidx += G) {
                const int i = sidx >> 8, v = sidx & 255, bh = v >> 3, s = v & 7, b_ = bh >> 3, h = bh & 7;
                const int qb = (i == 0) ? s : (i == 1) ? 15 - s : (i == 2) ? 16 + s : 31 - s;
                attn_unit<true>(L, (const bf16*)(rd + RD_QDA) + h * 128, 1024, (const bf16*)(rd + RD_KDA) + h * 128, (const bf16*)(rd + RD_VDA) + h * 128, 1024, (bf16*)(rd + RD_MIX) + h * 128, DM,
                                (size_t)b_ * SEQ + qb * 128, qb * 128, (size_t)b_ * SEQ, 2 * qb + 2, (const float*)(ws + WS_TBL) + h * 256, lam, 1.f - lam_init, P.in[16] + l * 128, tid, wave, lane);
            }
        }
        XSYNC();
        { PH_BEGIN(); hg_scan((bf16*)(ws + WS_H), (const float*)(ws + WS_DEC), gtid, NTH); }
        XSYNC();
        { PH_BEGIN();
          hg_out_units(L, bid, G, (const float*)(rd + RD_LOGF), (const bf16*)(rd + RD_QHG), (const bf16*)(rd + RD_IHG), (const bf16*)(rd + RD_GHG), (const bf16*)(ws + WS_H), P.in[17] + l * 128, (bf16*)(rd + RD_MIX), tid, wave, lane); }
        XSYNC();
        { PH_BEGIN(); EpiF32 E{(float*)(rd + RD_Y), DM}; run_gemm(L, tid, (const bf16*)(rd + RD_MIX), (const bf16*)(ws + WS_WOUT), T, DM, DM, E); }
        XSYNC();
        { PH_BEGIN();
          resnorm_rows((const float*)(rd + RD_Y), l == 0 ? P.in[0] : X, X, P.in[10] + l * DM, P.in[11] + l * DM, (bf16*)(ws + WS_H), gw, NGW, lane);
          norm_rows(P.in[1], MEMT, P.in[13] + l * DM, (bf16*)(rd + RD_MN), gw, NGW, lane); }
        XSYNC();
        { PH_BEGIN(); EpiB16 E{(bf16*)(rd + RD_QX), CXW, 0.08838834764831845f * LOG2E}; run_gemm(L, tid, (const bf16*)(ws + WS_H), (const bf16*)(ws + WS_WCQ), T, CXW, DM, E); }
        { PH_BEGIN(); EpiB16 E{(bf16*)(rd + RD_KV), 1024, 1.f}; run_gemm(L, tid, (const bf16*)(rd + RD_MN), (const bf16*)(ws + WS_WCKV), MEMT, 1024, DM, E, G / 2); }
        XSYNC();
        { PH_BEGIN();
          for (int u = (G == 256) ? (((bid & 7) << 5) | (bid >> 3)) : bid; u < 256; u += G) { const int b_ = u >> 6, h = (u >> 4) & 3, qb = u & 15; const bf16* KV = (const bf16*)(rd + RD_KV);
            attn_unit<false>(L, (const bf16*)(rd + RD_QX) + h * 128, CXW, KV + h * 128, KV + 512 + h * 128, 1024, (bf16*)(rd + RD_OX) + h * 128, CXW,
                             (size_t)b_ * SEQ + qb * 256, 0, (size_t)b_ * 256, 4, nullptr, 0.f, 1.f, nullptr, tid, wave, lane); } }
        XSYNC();
        { PH_BEGIN(); EpiF32 E{(float*)(rd + RD_Y), DM}; run_gemm(L, tid, (const bf16*)(rd + RD_OX), (const bf16*)(ws + WS_WCO), T, DM, CXW, E); }
        XSYNC();
        { PH_BEGIN(); resnorm_rows((const float*)(rd + RD_Y), X, X, P.in[12] + l * DM, P.in[14] + l * DM, (bf16*)(ws + WS_H), gw, NGW, lane); }
        XSYNC();
        { PH_BEGIN(); EpiSwiGLU E{(bf16*)(rd + RD_HID), FH}; run_gemm(L, tid, (const bf16*)(ws + WS_H), (const bf16*)(ws + WS_WFI), T, 2 * FH, DM, E); }
        XSYNC();
        { PH_BEGIN(); EpiF32 E{(float*)(rd + RD_Y), DM}; run_gemm(L, tid, (const bf16*)(rd + RD_HID), (const bf16*)(ws + WS_WFO), T, DM, FH, E); }
        XSYNC();
        if (l == 0) {
            { PH_BEGIN(); resnorm_rows((const float*)(rd + RD_Y), X, X, P.in[15] + l * DM, P.in[9] + DM, (bf16*)(ws + WS_H), gw, NGW, lane); }
            { PH_BEGIN(); convert_weights(P.in, 1, ws, L, gw, NGW, wave, lane); }
            XSYNC();
        } else {
            { PH_BEGIN(); resnorm_rows((const float*)(rd + RD_Y), X, X, P.in[15] + l * DM, nullptr, nullptr, gw, NGW, lane); }
        }
    }
}

extern "C" void kernel_launch(void* const* d_in, const int* in_sizes, int n_in, void* d_out, int out_size, void* d_ws, size_t ws_size, hipStream_t stream) {
    static int grid = 0;
    if (grid == 0) {
        if (n_in != 24 || out_size != T * DM || ws_size < WS_END) { fprintf(stderr, "kernel_launch: unexpected problem (n_in %d out %d ws %zu)\n", n_in, out_size, ws_size); grid = -1; return; }
        int dev = 0, cus = 0, per_cu = 0;
        hipGetDevice(&dev); hipDeviceGetAttribute(&cus, hipDeviceAttributeMultiprocessorCount, dev);
        hipFuncSetAttribute((const void*)mega_fwd, hipFuncAttributeMaxDynamicSharedMemorySize, LDS_BYTES);
        hipOccupancyMaxActiveBlocksPerMultiprocessor(&per_cu, (const void*)mega_fwd, 512, LDS_BYTES);
        if (per_cu < 1) { fprintf(stderr, "kernel_launch: occupancy query says %d blocks per CU\n", per_cu); per_cu = 1; }
        (void)hipGetLastError();
        grid = cus;
    }
    if (grid < 0) return;
    Params p{};
    for (int i = 0; i < 24; ++i) p.in[i] = (const float*)d_in[i];
    p.out = (float*)d_out; p.ws = (unsigned char*)d_ws;
    void* args[] = {&p};
    hipError_t e = hipLaunchCooperativeKernel((const void*)mega_fwd, dim3(grid), dim3(512), args, LDS_BYTES, stream);
    if (e != hipSuccess) fprintf(stderr, "cooperative launch failed: %s (grid %d)\n", hipGetErrorString(e), grid);
}
```

```cpp
#include <hip/hip_runtime.h>
#include <hip/hip_cooperative_groups.h>
#include <cstdio>
#include <cstdint>
namespace cg = cooperative_groups;
namespace pg8 {
#define PG8_LAS __attribute__((address_space(3)))
typedef unsigned short bf16_t;
typedef short bf16x8 __attribute__((ext_vector_type(8)));
typedef float f32x4 __attribute__((ext_vector_type(4)));
typedef unsigned u32x4 __attribute__((ext_vector_type(4)));
constexpr int BM = 256, BK = 64, HALF = 128, HTB = HALF * BK * 2  , STAGE_BYTES = 8 * HTB, NXCD = 8, WGM = 8;

__host__ __device__ __forceinline__ int lds_byte(int r, int c) { const int st = (r >> 4) * 2 + (c >> 5), rr = r & 15, cc = c & 31, ob = rr * 64 + cc * 2; return st * 1024 + (ob ^ (((ob >> 9) & 1) << 5)); }
__host__ __device__ __forceinline__ void stage_rc(int b, int& R, int& C) { const int st = b / 1024, sb = b % 1024, swz = sb ^ (((sb >> 9) & 1) << 5); R = (st >> 1) * 16 + swz / 64; C = (st & 1) * 32 + (swz % 64) / 2; }
__host__ __device__ __forceinline__ int perm32(int rho) { const int n = rho >> 4, i = rho & 15; return 8 * (i >> 2) + 4 * n + (i & 3); }

struct Unit { int pm, pn; };
struct Gemm { const bf16_t* A; const bf16_t* Bt; int M, N, K; };

struct StaticOrder {
    int nM, nN, nwg, G, c;
    __host__ __device__ void init(int M, int N, int G_, int c_) { nM = M / BM; nN = N / BM; nwg = nM * nN; G = G_; c = c_; }
    __host__ __device__ bool next(int i, Unit& u) const {
        const long L = (long)i * G + c; if (L >= nwg) return false;
        int wgid = (int)L; { const int q = nwg / NXCD, r = nwg % NXCD, xcd = wgid % NXCD, off = wgid / NXCD; wgid = (xcd < r ? xcd * (q + 1) : r * (q + 1) + (xcd - r) * q) + off; }
        const int nig = WGM * nN, gid = wgid / nig, fm = gid * WGM, gsz = (nM - fm) < WGM ? (nM - fm) : WGM;
        u.pm = fm + ((wgid % nig) % gsz); u.pn = (wgid % nig) / gsz; return true;
    }
    __device__ __forceinline__ void a_ready(const Unit&) const {}
    __device__ __forceinline__ void done(const Unit&) const {}
};
__device__ __forceinline__ unsigned cvt_pk_bf16(float lo, float hi) { unsigned r; asm volatile("v_cvt_pk_bf16_f32 %0, %1, %2" : "=v"(r) : "v"(lo), "v"(hi)); return r; }
typedef float f32x2 __attribute__((ext_vector_type(2)));
template <class Epi, class Sched, bool ALIGN_EPI = false, bool SP2 = false>
__device__ __forceinline__ void gemm_phase(PG8_LAS unsigned char* lds, const Gemm g, const Sched& S, const Epi& E, int tid_in) {
    int tid = tid_in; asm volatile("" : "+v"(tid)); const int wid = __builtin_amdgcn_readfirstlane(tid >> 6), lane = tid & 63, wr = wid >> 2, wc = wid & 3, fr = lane & 15, fq = lane >> 4;
    const int K = g.K, nt = K / BK;
    unsigned voffA[2], voffB[2];
#pragma unroll
    for (int i = 0; i < 2; ++i) { int R, C; stage_rc(tid * 16 + i * 8192, R, C); const int Rb = Epi::PERM ? ((R & ~31) + perm32(R & 31)) : R;
        voffA[i] = (unsigned)(R * K + C) * 2u; voffB[i] = (unsigned)(Rb * K + C) * 2u; }
    const size_t kstep = (size_t)(BK * 2);
    const size_t hstep = (size_t)HALF * K * 2;
    const size_t tstep = 2 * hstep;
    const unsigned ldsw = (unsigned)wid * 1024u;
    const int aoff = lds_byte(wr * 64 + fr, fq * 8), boff = lds_byte(wc * 32 + fr, fq * 8);
#define PG8_SA(b, h) (((b) * 2 + (h)) * HTB)
#define PG8_SB(b, h) ((4 + (b) * 2 + (h)) * HTB)
#define PG8_STAGE(bufoff, gbase, voff) do { _Pragma("unroll") for (int _i = 0; _i < 2; ++_i) \
        __builtin_amdgcn_global_load_lds((const unsigned*)((const char*)(gbase) + (voff)[_i]), (PG8_LAS unsigned*)(lds + (bufoff) + ldsw + _i * 8192), 16, 0, 0); } while (0)
#define PG8_LDA(dst, b, h) do { _Pragma("unroll") for (int m = 0; m < 4; ++m) _Pragma("unroll") for (int k = 0; k < 2; ++k) dst[m][k] = *(const PG8_LAS bf16x8*)(lds + PG8_SA(b, h) + aoff + m * 2048 + k * 1024); } while (0)
#define PG8_LDB(dst, b, h) do { _Pragma("unroll") for (int n = 0; n < 2; ++n) _Pragma("unroll") for (int k = 0; k < 2; ++k) dst[n][k] = *(const PG8_LAS bf16x8*)(lds + PG8_SB(b, h) + boff + n * 2048 + k * 1024); } while (0)
#define PG8_MMA(ai, bj, At, Bt) do { __builtin_amdgcn_s_setprio(1); _Pragma("unroll") for (int m = 0; m < 4; ++m) _Pragma("unroll") for (int n = 0; n < 2; ++n) _Pragma("unroll") for (int k = 0; k < 2; ++k) \
        acc[ai][bj][m][n] = __builtin_amdgcn_mfma_f32_16x16x32_bf16(Bt[n][k], At[m][k], acc[ai][bj][m][n], 0, 0, 0); __builtin_amdgcn_s_setprio(0); } while (0)
#define PG8_WAIT_V(n) asm volatile("s_waitcnt vmcnt(" #n ")" ::: "memory")
#define PG8_WAIT_L(n) asm volatile("s_waitcnt lgkmcnt(" #n ")" ::: "memory")
#define PG8_BAR __builtin_amdgcn_s_barrier()
#define PG8_SCHED __builtin_amdgcn_sched_barrier(0)
    Unit cur, nxt; int ui = 0;
    if (!S.next(0, cur)) return;
    f32x4 acc[2][2][4][2];
#pragma unroll
    for (int a = 0; a < 2; ++a)
#pragma unroll
        for (int b = 0; b < 2; ++b)
#pragma unroll
            for (int m = 0; m < 4; ++m)
#pragma unroll
                for (int n = 0; n < 2; ++n) acc[a][b][m][n] = (f32x4){0.f, 0.f, 0.f, 0.f};
    bf16x8 At[4][2], B0[2][2], B1[2][2];
    const char* cA = (const char*)g.A + (size_t)cur.pm * tstep; const char* cB = (const char*)g.Bt + (size_t)cur.pn * tstep;
    S.a_ready(cur);
    if constexpr (SP2) {
        PG8_STAGE(PG8_SB(0, 0), cB, voffB); PG8_STAGE(PG8_SB(0, 1), cB + hstep, voffB); PG8_STAGE(PG8_SA(0, 0), cA, voffA); PG8_STAGE(PG8_SA(0, 1), cA + hstep, voffA);
        if (wr == 1) PG8_BAR;
        PG8_WAIT_V(2); PG8_BAR;
        PG8_STAGE(PG8_SB(1, 0), cB + kstep, voffB); PG8_STAGE(PG8_SA(1, 0), cA + kstep, voffA); PG8_STAGE(PG8_SB(1, 1), cB + hstep + kstep, voffB);
        PG8_WAIT_V(6); PG8_BAR;
    } else {
        PG8_STAGE(PG8_SB(0, 0), cB, voffB); PG8_STAGE(PG8_SA(0, 0), cA, voffA); PG8_STAGE(PG8_SB(0, 1), cB + hstep, voffB); PG8_STAGE(PG8_SA(0, 1), cA + hstep, voffA);
        if (wr == 1) PG8_BAR;
        PG8_WAIT_V(4); PG8_BAR;
        PG8_STAGE(PG8_SB(1, 0), cB + kstep, voffB); PG8_STAGE(PG8_SA(1, 0), cA + kstep, voffA); PG8_STAGE(PG8_SB(1, 1), cB + hstep + kstep, voffB);
        PG8_WAIT_V(6); PG8_BAR;
    }
    for (;;) {
        const bool has_next = S.next(ui + 1, nxt);
        const char* nA = has_next ? (const char*)g.A + (size_t)nxt.pm * tstep : cA; const char* nB = has_next ? (const char*)g.Bt + (size_t)nxt.pn * tstep : cB;
        for (int t = 0; t < nt; t += 2) {
            const bool last = (t == nt - 2);
            const char* a1 = cA + (size_t)(t + 1) * kstep;
            const char* a2 = last ? nA : cA + (size_t)(t + 2) * kstep; const char* b2 = last ? nB : cB + (size_t)(t + 2) * kstep;
            const char* a3 = a2 + kstep; const char* b3 = b2 + kstep;
            if (last && has_next) S.a_ready(nxt);
            if constexpr (SP2) {
            PG8_LDB(B0, 0, 0); PG8_LDB(B1, 0, 1); PG8_SCHED; PG8_LDA(At, 0, 0); PG8_STAGE(PG8_SA(1, 1), a1 + hstep, voffA);
            PG8_WAIT_V(8); PG8_WAIT_L(0); PG8_BAR; PG8_MMA(0, 0, At, B0); PG8_MMA(0, 1, At, B1); PG8_BAR; PG8_SCHED;
            PG8_LDA(At, 0, 1); PG8_STAGE(PG8_SB(0, 0), b2, voffB); PG8_STAGE(PG8_SB(0, 1), b2 + hstep, voffB); PG8_STAGE(PG8_SA(0, 0), a2, voffA);
            PG8_WAIT_V(8); PG8_WAIT_L(0); PG8_BAR; PG8_MMA(1, 0, At, B0); PG8_MMA(1, 1, At, B1); PG8_BAR; PG8_SCHED;
            PG8_LDB(B0, 1, 0); PG8_LDB(B1, 1, 1); PG8_SCHED; PG8_LDA(At, 1, 0); PG8_STAGE(PG8_SA(0, 1), a2 + hstep, voffA);
            PG8_WAIT_V(8); PG8_WAIT_L(0); PG8_BAR; PG8_MMA(0, 0, At, B0); PG8_MMA(0, 1, At, B1); PG8_BAR; PG8_SCHED;
            PG8_LDA(At, 1, 1); PG8_STAGE(PG8_SB(1, 0), b3, voffB); PG8_STAGE(PG8_SB(1, 1), b3 + hstep, voffB); PG8_STAGE(PG8_SA(1, 0), a3, voffA);
            PG8_WAIT_V(8); PG8_WAIT_L(0); PG8_BAR; PG8_MMA(1, 0, At, B0); PG8_MMA(1, 1, At, B1); PG8_BAR; PG8_SCHED;
            } else {
            PG8_LDB(B0, 0, 0); PG8_SCHED; PG8_LDA(At, 0, 0); PG8_STAGE(PG8_SA(1, 1), a1 + hstep, voffA);
            PG8_WAIT_L(8); PG8_BAR; PG8_WAIT_L(0); PG8_MMA(0, 0, At, B0); PG8_BAR; PG8_SCHED;
            PG8_LDB(B1, 0, 1); PG8_STAGE(PG8_SB(0, 0), b2, voffB);
            PG8_BAR; PG8_WAIT_L(0); PG8_MMA(0, 1, At, B1); PG8_BAR;
            PG8_LDA(At, 0, 1); PG8_STAGE(PG8_SA(0, 0), a2, voffA);
            PG8_BAR; PG8_WAIT_L(0); PG8_MMA(1, 0, At, B0); PG8_BAR; PG8_SCHED;
            PG8_STAGE(PG8_SB(0, 1), b2 + hstep, voffB);
            PG8_WAIT_V(6); PG8_BAR; PG8_MMA(1, 1, At, B1); PG8_BAR;
            PG8_LDB(B0, 1, 0); PG8_SCHED; PG8_LDA(At, 1, 0); PG8_STAGE(PG8_SA(0, 1), a2 + hstep, voffA);
            PG8_WAIT_L(8); PG8_BAR; PG8_WAIT_L(0); PG8_MMA(0, 0, At, B0); PG8_BAR; PG8_SCHED;
            PG8_LDB(B1, 1, 1); PG8_STAGE(PG8_SB(1, 0), b3, voffB);
            PG8_BAR; PG8_WAIT_L(0); PG8_MMA(0, 1, At, B1); PG8_BAR;
            PG8_LDA(At, 1, 1); PG8_STAGE(PG8_SA(1, 0), a3, voffA);
            PG8_BAR; PG8_WAIT_L(0); PG8_MMA(1, 0, At, B0); PG8_BAR; PG8_SCHED;
            PG8_STAGE(PG8_SB(1, 1), b3 + hstep, voffB);
            PG8_WAIT_V(6); PG8_BAR; PG8_MMA(1, 1, At, B1); PG8_BAR;
            }
        }
        if constexpr (ALIGN_EPI) { if (wr == 0) PG8_BAR; }
        if constexpr (!Epi::AFTER_DRAIN) { E(acc, cur, wr, wc, fr, fq); S.done(cur); }
        if (!has_next) break;
#pragma unroll
        for (int a = 0; a < 2; ++a)
#pragma unroll
            for (int b = 0; b < 2; ++b)
#pragma unroll
                for (int m = 0; m < 4; ++m)
#pragma unroll
                    for (int n = 0; n < 2; ++n) acc[a][b][m][n] = (f32x4){0.f, 0.f, 0.f, 0.f};
        cur = nxt; cA = nA; cB = nB; ++ui;
        if constexpr (ALIGN_EPI) { if (wr == 1) PG8_BAR; }
    }
    PG8_WAIT_V(0);
    if constexpr (!ALIGN_EPI) { if (wr == 0) PG8_BAR; }
    PG8_BAR;
    if constexpr (Epi::AFTER_DRAIN) { E.fused(acc, cur, wr, wc, fr, fq, lds, wid, lane); S.done(cur); }
#undef PG8_SA
#undef PG8_SB
#undef PG8_STAGE
#undef PG8_LDA
#undef PG8_LDB
#undef PG8_MMA
#undef PG8_WAIT_V
#undef PG8_WAIT_L
#undef PG8_BAR
#undef PG8_SCHED
}
}

#define LAS __attribute__((address_space(3)))
#define DI __device__ __forceinline__
typedef unsigned short bf16;
typedef short bf16x8 __attribute__((ext_vector_type(8)));
typedef short s16x4 __attribute__((ext_vector_type(4)));
typedef float f32x4 __attribute__((ext_vector_type(4)));
typedef float f32x16 __attribute__((ext_vector_type(16)));
typedef unsigned u32x4 __attribute__((ext_vector_type(4)));
typedef unsigned u32x2 __attribute__((ext_vector_type(2)));
typedef short v4i16_t __attribute__((ext_vector_type(4)));

constexpr int T = 16384, DM = 2048, SEQ = 4096, INC = 7168, FH = 5632, MEMT = 1024, CXW = 512;
constexpr float EPS = 1e-6f, LOG2E = 1.4426950408889634f;
constexpr size_t MiB = 1u << 20;
constexpr size_t WS_WIN = 0, WS_WOUT = 28 * MiB, WS_WCQ = 36 * MiB, WS_WCKV = 38 * MiB, WS_WCO = 42 * MiB, WS_WFI = 44 * MiB, WS_WFO = 88 * MiB;
constexpr size_t WS_DEC = 110 * MiB, WS_LB = 111 * MiB, WS_H = 112 * MiB, WS_RD = 176 * MiB, WS_END = 496 * MiB;
constexpr size_t RD_MIX = 0, RD_QDA = 64 * MiB, RD_QHG = 96 * MiB, RD_KDA = 128 * MiB, RD_VDA = 160 * MiB, RD_IHG = 192 * MiB, RD_GHG = 224 * MiB, RD_LOGF = 256 * MiB;
constexpr size_t RD_Y = 192 * MiB, RD_HID = 0, RD_QX = 128 * MiB, RD_OX = 144 * MiB, RD_KV = 160 * MiB, RD_MN = 164 * MiB;
constexpr size_t WS_TBL = 111 * MiB + 256 * 1024;
constexpr size_t WS_BAR = 111 * MiB + 512 * 1024;
constexpr int LDS_BYTES = 147456, LDS_MISC = 131072 + 256;

DI float bf2f(bf16 b) { return __uint_as_float((unsigned)b << 16); }
typedef float f32x2_t __attribute__((ext_vector_type(2))); typedef __bf16 bf16x2_t __attribute__((ext_vector_type(2)));
DI unsigned pk2(float lo, float hi) { f32x2_t v = {lo, hi}; bf16x2_t b = __builtin_convertvector(v, bf16x2_t); return __builtin_bit_cast(unsigned, b); }
DI float fexp(float x) { return __builtin_amdgcn_exp2f(x * LOG2E); }
DI int lane_id_opaque() { unsigned m = ~0u; asm volatile("" : "+s"(m)); return (int)__builtin_amdgcn_mbcnt_hi(m, __builtin_amdgcn_mbcnt_lo(m, 0u)); }
DI float shflx(float v, int mask) { return __uint_as_float((unsigned)__builtin_amdgcn_ds_bpermute((lane_id_opaque() ^ mask) << 2, (int)__float_as_uint(v))); }
DI float xmax32(float v) { auto rr = __builtin_amdgcn_permlane32_swap(__float_as_uint(v), __float_as_uint(v), false, false); return fmaxf(__uint_as_float(rr[0]), __uint_as_float(rr[1])); }
DI float xsum32(float v) { auto rr = __builtin_amdgcn_permlane32_swap(__float_as_uint(v), __float_as_uint(v), false, false); return __uint_as_float(rr[0]) + __uint_as_float(rr[1]); }
DI float wave_sum(float v) {
#pragma unroll
    for (int o = 1; o < 64; o <<= 1) v += shflx(v, o);
    return v;
}
DI int crow(int i, int h) { return (i & 3) + 8 * (i >> 2) + 4 * h; }
#define LDS_WAIT() asm volatile("s_waitcnt lgkmcnt(0)" ::: "memory")

struct EpiF32 {
    static constexpr bool PERM = false, AFTER_DRAIN = false;
    float* O; int ldc;
    DI void operator()(const pg8::f32x4 (&acc)[2][2][4][2], const pg8::Unit& u, int wr, int wc, int fr, int fq) const {
        const int row0 = u.pm * 256 + wr * 64 + fr, col0 = u.pn * 256 + wc * 32 + 4 * fq;
#pragma unroll
        for (int ai = 0; ai < 2; ++ai)
#pragma unroll
            for (int m = 0; m < 4; ++m) { float* rowp = O + (size_t)(row0 + ai * 128 + m * 16) * ldc + col0;
#pragma unroll
                for (int bj = 0; bj < 2; ++bj) { *(f32x4*)(rowp + bj * 128) = acc[ai][bj][m][0]; *(f32x4*)(rowp + bj * 128 + 16) = acc[ai][bj][m][1]; } }
    }
};
struct EpiB16 {
    static constexpr bool PERM = true, AFTER_DRAIN = false;
    bf16* O; int ldc; float scale;
    DI void operator()(const pg8::f32x4 (&acc)[2][2][4][2], const pg8::Unit& u, int wr, int wc, int fr, int fq) const {
        const int row0 = u.pm * 256 + wr * 64 + fr, col0 = u.pn * 256 + wc * 32 + 8 * fq;
#pragma unroll
        for (int ai = 0; ai < 2; ++ai)
#pragma unroll
            for (int m = 0; m < 4; ++m) { bf16* rowp = O + (size_t)(row0 + ai * 128 + m * 16) * ldc + col0;
#pragma unroll
                for (int bj = 0; bj < 2; ++bj) { const pg8::f32x4 v0 = acc[ai][bj][m][0] * scale, v1 = acc[ai][bj][m][1] * scale;
                    u32x4 w; w.x = pk2(v0[0], v0[1]); w.y = pk2(v0[2], v0[3]); w.z = pk2(v1[0], v1[1]); w.w = pk2(v1[2], v1[3]);
                    *(u32x4*)(rowp + bj * 128) = w; } }
    }
};
struct EpiSwiGLU {
    static constexpr bool PERM = true, AFTER_DRAIN = false;
    bf16* O; int ldc;
    DI void operator()(const pg8::f32x4 (&acc)[2][2][4][2], const pg8::Unit& u, int wr, int wc, int fr, int fq) const {
        const int row0 = u.pm * 256 + wr * 64 + fr, col0 = u.pn * 128 + wc * 32 + 8 * fq;
#pragma unroll
        for (int ai = 0; ai < 2; ++ai)
#pragma unroll
            for (int m = 0; m < 4; ++m) { bf16* rowp = O + (size_t)(row0 + ai * 128 + m * 16) * ldc + col0;
                float r[8];
#pragma unroll
                for (int n = 0; n < 2; ++n)
#pragma unroll
                    for (int j = 0; j < 4; ++j) { const float gt = acc[ai][0][m][n][j], up = acc[ai][1][m][n][j]; r[n * 4 + j] = gt * up * __builtin_amdgcn_rcpf(1.f + fexp(-gt)); }
                u32x4 w; w.x = pk2(r[0], r[1]); w.y = pk2(r[2], r[3]); w.z = pk2(r[4], r[5]); w.w = pk2(r[6], r[7]);
                *(u32x4*)rowp = w; }
    }
};
struct EpiInProj {
    static constexpr bool PERM = true, AFTER_DRAIN = false;
    unsigned char* rd; const float* lb;
    DI void operator()(const pg8::f32x4 (&acc)[2][2][4][2], const pg8::Unit& u, int wr, int wc, int fr, int fq) const {
        const int seg = u.pn >> 2, row0 = u.pm * 256 + wr * 64 + fr, col0 = (u.pn & 3) * 256 + wc * 32 + 8 * fq;
        if (seg == 3) {
            float* O = (float*)(rd + RD_LOGF);
            float lbv[2][8];
#pragma unroll
            for (int bj = 0; bj < 2; ++bj)
#pragma unroll
                for (int j = 0; j < 8; ++j) lbv[bj][j] = lb[col0 + bj * 128 + j];
#pragma unroll
            for (int ai = 0; ai < 2; ++ai)
#pragma unroll
                for (int m = 0; m < 4; ++m) { float* rowp = O + (size_t)(row0 + ai * 128 + m * 16) * 1024 + col0;
#pragma unroll
                    for (int bj = 0; bj < 2; ++bj)
#pragma unroll
                        for (int n = 0; n < 2; ++n) { f32x4 o;
#pragma unroll
                            for (int j = 0; j < 4; ++j) { const float z = acc[ai][bj][m][n][j], l0 = lbv[bj][n * 4 + j];
                                const float sg = __builtin_amdgcn_rcpf(1.f + fexp(-z)); const float f = fmaxf(l0 + (1.f - l0) * sg, 1e-30f); o[j] = __logf(f); }
                            *(f32x4*)(rowp + bj * 128 + n * 4) = o; } }
        } else {
            const unsigned slot = (0x7630542u >> (4 * seg)) & 15u;
            const float sc = (seg == 0) ? 0.125f * LOG2E : 1.f;
            bf16* O = (bf16*)(rd + (size_t)slot * (32 * MiB));
#pragma unroll
            for (int ai = 0; ai < 2; ++ai)
#pragma unroll
                for (int m = 0; m < 4; ++m) { bf16* rowp = O + (size_t)(row0 + ai * 128 + m * 16) * 1024 + col0;
#pragma unroll
                    for (int bj = 0; bj < 2; ++bj) { const pg8::f32x4 v0 = acc[ai][bj][m][0] * sc, v1 = acc[ai][bj][m][1] * sc;
                        u32x4 w; w.x = pk2(v0[0], v0[1]); w.y = pk2(v0[2], v0[3]); w.z = pk2(v1[0], v1[1]); w.w = pk2(v1[2], v1[3]);
                        *(u32x4*)(rowp + bj * 128) = w; } }
        }
    }
};

template <int MODE> DI void transpose_item(const float* W, int K, int N, bf16* WT, LAS float* scr, int item, int lane) {
    const int nblk = N / 32, kb = item / nblk, nb = item % nblk, k0 = 64 * kb, n0 = 32 * nb;
    { float tmp[32]; const float* wp = W + (size_t)(k0 + (lane >> 5)) * N + n0 + (lane & 31);
#pragma unroll
      for (int i = 0; i < 32; ++i) tmp[i] = __builtin_nontemporal_load(wp + (size_t)(2 * i) * N);
#pragma unroll
      for (int i = 0; i < 32; ++i) scr[(2 * i + (lane >> 5)) * 33 + (lane & 31)] = tmp[i]; }
    LDS_WAIT(); asm volatile("" ::: "memory");
    const int c = lane & 7;
#pragma unroll
    for (int j = 0; j < 4; ++j) { const int n = (lane >> 3) + 8 * j; const LAS float* s = scr + (8 * c) * 33 + n;
        u32x4 o; o.x = pk2(s[0 * 33], s[1 * 33]); o.y = pk2(s[2 * 33], s[3 * 33]); o.z = pk2(s[4 * 33], s[5 * 33]); o.w = pk2(s[6 * 33], s[7 * 33]);
        int nn = n0 + n;
        if (MODE == 1) { if (nn < FH) nn = (nn >> 7) * 256 + (nn & 127); else { nn -= FH; nn = (nn >> 7) * 256 + 128 + (nn & 127); } }
        *(u32x4*)(WT + (size_t)nn * K + k0 + 8 * c) = o; }
    LDS_WAIT(); asm volatile("" ::: "memory");
}
DI void convert_weights(const float* const* in, int l, unsigned char* ws, LAS unsigned char* L, int gw, int NGW, int wave, int lane) {
    LAS float* scr = (LAS float*)(L + wave * 16384);
    constexpr int I_IN = 32 * (INC / 32), I_OUT = 32 * 64, I_CQ = 32 * 16, I_CKV = 32 * 32, I_CO = 8 * 64, I_FI = 32 * (2 * FH / 32), I_FO = (FH / 64) * 64;
    constexpr int NITEMS = I_IN + I_OUT + I_CQ + I_CKV + I_CO + I_FI + I_FO;
    for (int it = gw; it < NITEMS; it += NGW) {
        int r = it;
        if (r < I_IN) { transpose_item<0>(in[2] + (size_t)l * DM * INC, DM, INC, (bf16*)(ws + WS_WIN), scr, r, lane); continue; } r -= I_IN;
        if (r < I_OUT) { transpose_item<0>(in[3] + (size_t)l * DM * DM, DM, DM, (bf16*)(ws + WS_WOUT), scr, r, lane); continue; } r -= I_OUT;
        if (r < I_CQ) { transpose_item<0>(in[4] + (size_t)l * DM * CXW, DM, CXW, (bf16*)(ws + WS_WCQ), scr, r, lane); continue; } r -= I_CQ;
        if (r < I_CKV) { transpose_item<0>(in[5] + (size_t)l * DM * 1024, DM, 1024, (bf16*)(ws + WS_WCKV), scr, r, lane); continue; } r -= I_CKV;
        if (r < I_CO) { transpose_item<0>(in[6] + (size_t)l * CXW * DM, CXW, DM, (bf16*)(ws + WS_WCO), scr, r, lane); continue; } r -= I_CO;
        if (r < I_FI) { transpose_item<1>(in[7] + (size_t)l * DM * 2 * FH, DM, 2 * FH, (bf16*)(ws + WS_WFI), scr, r, lane); continue; } r -= I_FI;
        transpose_item<0>(in[8] + (size_t)l * FH * DM, FH, DM, (bf16*)(ws + WS_WFO), scr, r, lane);
    }
}

DI void norm_rows(const float* src, int nrows, const float* g, bf16* dst, int gw, int NGW, int lane) {
    int row = gw; if (row >= nrows) return;
    f32x4 v[8], vn[8];
    { const f32x4* xr = (const f32x4*)(src + (size_t)row * DM) + lane;
#pragma unroll
      for (int j = 0; j < 8; ++j) v[j] = __builtin_nontemporal_load(xr + 64 * j); }
    for (;;) {
        const int nrow = row + NGW; const bool has = nrow < nrows;
        if (has) { const f32x4* xr = (const f32x4*)(src + (size_t)nrow * DM) + lane;
#pragma unroll
            for (int j = 0; j < 8; ++j) vn[j] = __builtin_nontemporal_load(xr + 64 * j); }
        float ss = 0.f;
#pragma unroll
        for (int j = 0; j < 8; ++j) ss += (v[j].x * v[j].x + v[j].y * v[j].y) + (v[j].z * v[j].z + v[j].w * v[j].w);
        const float r = rsqrtf(wave_sum(ss) * (1.f / DM) + EPS);
        u32x2* o = (u32x2*)(dst + (size_t)row * DM) + lane;
#pragma unroll
        for (int j = 0; j < 8; ++j) { const f32x4 gg = ((const f32x4*)g)[lane + 64 * j]; u32x2 w; w.x = pk2(v[j].x * r * gg.x, v[j].y * r * gg.y); w.y = pk2(v[j].z * r * gg.z, v[j].w * r * gg.w); o[64 * j] = w; }
        if (!has) break;
#pragma unroll
        for (int j = 0; j < 8; ++j) v[j] = vn[j];
        row = nrow;
    }
}
DI void resnorm_rows(const float* Y, const float* Xs, float* Xd, const float* gpost, const float* gpre, bf16* H, int gw, int NGW, int lane) {
    int row = gw; if (row >= T) return;
    f32x4 y[8], x[8], yn[8], xn[8];
    { const f32x4* yr = (const f32x4*)(Y + (size_t)row * DM) + lane; const f32x4* xr = (const f32x4*)(Xs + (size_t)row * DM) + lane;
#pragma unroll
      for (int j = 0; j < 8; ++j) { y[j] = __builtin_nontemporal_load(yr + 64 * j); x[j] = __builtin_nontemporal_load(xr + 64 * j); } }
    for (;;) {
        const int nrow = row + NGW; const bool has = nrow < T;
        if (has) { const f32x4* yr = (const f32x4*)(Y + (size_t)nrow * DM) + lane; const f32x4* xr = (const f32x4*)(Xs + (size_t)nrow * DM) + lane;
#pragma unroll
            for (int j = 0; j < 8; ++j) { yn[j] = __builtin_nontemporal_load(yr + 64 * j); xn[j] = __builtin_nontemporal_load(xr + 64 * j); } }
        float ss = 0.f;
#pragma unroll
        for (int j = 0; j < 8; ++j) ss += (y[j].x * y[j].x + y[j].y * y[j].y) + (y[j].z * y[j].z + y[j].w * y[j].w);
        const float r = rsqrtf(wave_sum(ss) * (1.f / DM) + EPS);
        f32x4* xo = (f32x4*)(Xd + (size_t)row * DM) + lane; float s2 = 0.f;
#pragma unroll
        for (int j = 0; j < 8; ++j) { const f32x4 gg = ((const f32x4*)gpost)[lane + 64 * j]; x[j] = x[j] + y[j] * r * gg; __builtin_nontemporal_store(x[j], xo + 64 * j);
            s2 += (x[j].x * x[j].x + x[j].y * x[j].y) + (x[j].z * x[j].z + x[j].w * x[j].w); }
        if (H) {
            const float r2 = rsqrtf(wave_sum(s2) * (1.f / DM) + EPS);
            u32x2* o = (u32x2*)(H + (size_t)row * DM) + lane;
#pragma unroll
            for (int j = 0; j < 8; ++j) { const f32x4 gg = ((const f32x4*)gpre)[lane + 64 * j]; u32x2 w; w.x = pk2(x[j].x * r2 * gg.x, x[j].y * r2 * gg.y); w.y = pk2(x[j].z * r2 * gg.z, x[j].w * r2 * gg.w); o[64 * j] = w; }
        }
        if (!has) break;
#pragma unroll
        for (int j = 0; j < 8; ++j) { y[j] = yn[j]; x[j] = xn[j]; }
        row = nrow;
    }
}

DI void hg_state_units(LAS unsigned char* L, int u0, int G, const float* LOGF, const bf16* IHG, bf16* ST, float* DEC, int tid, int wave, int lane) {
    LAS bf16* KhT = (LAS bf16*)L;
    LAS bf16* Vs = (LAS bf16*)(L + 18432);
    LAS float* segtot = (LAS float*)(L + 38912);
    const int c = tid & 127, seg = tid >> 7;
    int unit = u0; if (unit >= 2048) return;
    float g[16]; bf16x8 v8[2];
#define HGS_LOAD(u_) do { const int bh_ = (u_) >> 6, n_ = (u_) & 63; const size_t tk_ = (size_t)(bh_ >> 3) * SEQ + n_ * 64; const int hc_ = (bh_ & 7) * 128; \
        _Pragma("unroll") for (int i = 0; i < 16; ++i) g[i] = LOGF[(tk_ + 16 * seg + i) * 1024 + hc_ + c]; \
        _Pragma("unroll") for (int i = 0; i < 2; ++i) { const int cid = tid + 512 * i, kv = cid >> 4, dvs = (cid & 15) * 8; v8[i] = *(const bf16x8*)(IHG + (tk_ + kv) * 1024 + hc_ + dvs); } } while (0)
    HGS_LOAD(unit);
    for (;;) {
        float tot = 0.f;
#pragma unroll
        for (int i = 0; i < 16; ++i) tot += g[i];
        segtot[seg * 128 + c] = tot;
#pragma unroll
        for (int i = 0; i < 2; ++i) { const int cid = tid + 512 * i, kv = cid >> 4, dvs = (cid & 15) * 8; *(LAS bf16x8*)(Vs + kv * 160 + dvs) = v8[i]; }
        __syncthreads();
        float off = 0.f, total = 0.f;
#pragma unroll
        for (int s = 0; s < 4; ++s) { const float t_ = segtot[s * 128 + c]; if (s < seg) off += t_; total += t_; }
        float run = off; float kh[16];
#pragma unroll
        for (int i = 0; i < 16; ++i) { run += g[i]; kh[i] = (1.f - fexp(g[i])) * fexp(total - run); }
        { u32x4 w0, w1; w0.x = pk2(kh[0], kh[1]); w0.y = pk2(kh[2], kh[3]); w0.z = pk2(kh[4], kh[5]); w0.w = pk2(kh[6], kh[7]);
          w1.x = pk2(kh[8], kh[9]); w1.y = pk2(kh[10], kh[11]); w1.z = pk2(kh[12], kh[13]); w1.w = pk2(kh[14], kh[15]);
          *(LAS u32x4*)(KhT + c * 72 + 16 * seg) = w0; *(LAS u32x4*)(KhT + c * 72 + 16 * seg + 8) = w1; }
        if (seg == 0) DEC[(size_t)unit * 128 + c] = fexp(total);
        const int nunit = unit + G; const bool has = nunit < 2048;
        if (has) HGS_LOAD(nunit);
        __syncthreads();
        const int lr = lane & 15, quad = lane >> 4;
        bf16x8 bfr[2];
#pragma unroll
        for (int ks = 0; ks < 2; ++ks) { const LAS bf16* vp = Vs + (32 * ks + quad * 8 + (lr >> 2)) * 160 + 16 * wave + 4 * (lr & 3);
            const s16x4 lo = __builtin_bit_cast(s16x4, __builtin_amdgcn_ds_read_tr16_b64_v4i16((LAS v4i16_t*)vp)), hi = __builtin_bit_cast(s16x4, __builtin_amdgcn_ds_read_tr16_b64_v4i16((LAS v4i16_t*)(vp + 4 * 160)));
            bfr[ks] = __builtin_shufflevector(lo, hi, 0, 1, 2, 3, 4, 5, 6, 7); }
        bf16* dst = ST + (size_t)unit * 16384 + (size_t)(16 * wave + lr) * 128 + quad * 4;
#pragma unroll
        for (int ct = 0; ct < 8; ++ct) {
            pg8::f32x4 acc = {0.f, 0.f, 0.f, 0.f};
#pragma unroll
            for (int ks = 0; ks < 2; ++ks) { const bf16x8 a = *(const LAS bf16x8*)(KhT + (16 * ct + lr) * 72 + 32 * ks + quad * 8); acc = __builtin_amdgcn_mfma_f32_16x16x32_bf16(a, bfr[ks], acc, 0, 0, 0); }
            u32x2 w; w.x = pk2(acc[0], acc[1]); w.y = pk2(acc[2], acc[3]); *(u32x2*)(dst + 16 * ct) = w;
        }
        __syncthreads();
        if (!has) break;
        unit = nunit;
    }
#undef HGS_LOAD
}
DI void hg_scan(bf16* ST, const float* DEC, int gtid, int NTH) {
    for (int e = gtid; e < 32 * 4096; e += NTH) {
        const int bh = e >> 12, rem = e & 4095, dv = rem >> 5, c = (rem & 31) * 4;
        f32x4 S = {0.f, 0.f, 0.f, 0.f};
        bf16* p = ST + (size_t)bh * 64 * 16384 + dv * 128 + c; const float* dp = DEC + (size_t)bh * 64 * 128 + c;
#pragma unroll 8
        for (int n = 0; n < 64; ++n) {
            const u32x2 u = *(const u32x2*)(p + (size_t)n * 16384); const f32x4 d = *(const f32x4*)(dp + n * 128);
            u32x2 w; w.x = pk2(S.x, S.y); w.y = pk2(S.z, S.w); *(u32x2*)(p + (size_t)n * 16384) = w;
            f32x4 uf; uf.x = __uint_as_float(u.x << 16); uf.y = __uint_as_float(u.x & 0xffff0000u); uf.z = __uint_as_float(u.y << 16); uf.w = __uint_as_float(u.y & 0xffff0000u);
            S = d * S + uf;
        }
    }
}
DI void hg_out_units(LAS unsigned char* L, int u0, int G, const float* LOGF, const bf16* QHG, const bf16* IHG, const bf16* GHG, const bf16* ST, const float* og, bf16* MIX, int tid, int wave, int lane) {
    LAS bf16* Qt = (LAS bf16*)L;
    LAS bf16* Kt = (LAS bf16*)(L + 17408);
    LAS bf16* Qh = (LAS bf16*)(L + 34816);
    LAS bf16* Vs = (LAS bf16*)(L + 52224);
    LAS bf16* At = (LAS bf16*)(L + 72704);
    LAS float* segtot = (LAS float*)(L + 81920);
    LAS float* ssq = (LAS float*)(L + 83968);
    const int c = tid & 127, seg = tid >> 7;
    const int lr = lane & 15, quad = lane >> 4, tt = wave >> 1, dh = wave & 1;
    int unit = u0; if (unit >= 2048) return;
    float g[16]; bf16 qraw[16]; bf16x8 v8[2];
#define HGO_LOAD(u_) do { const int bh_ = (u_) >> 6, n_ = (u_) & 63; const size_t tk_ = (size_t)(bh_ >> 3) * SEQ + n_ * 64; const int hc_ = (bh_ & 7) * 128; \
        _Pragma("unroll") for (int i = 0; i < 16; ++i) { g[i] = LOGF[(tk_ + 16 * seg + i) * 1024 + hc_ + c]; qraw[i] = QHG[(tk_ + 16 * seg + i) * 1024 + hc_ + c]; } \
        _Pragma("unroll") for (int i = 0; i < 2; ++i) { const int cid = tid + 512 * i, kv = cid >> 4, dvs = (cid & 15) * 8; v8[i] = *(const bf16x8*)(IHG + (tk_ + kv) * 1024 + hc_ + dvs); } } while (0)
    HGO_LOAD(unit);
    for (;;) {
    const int bh = unit >> 6, n = unit & 63, b_ = bh >> 3, h = bh & 7; const size_t tok0 = (size_t)b_ * SEQ + n * 64;
    const bf16* stp = ST + (size_t)unit * 16384;
    bf16x8 stf[4][4]; u32x2 gtv[4];
#pragma unroll
    for (int d = 0; d < 4; ++d) { const int dt = 4 * dh + d;
#pragma unroll
        for (int ks = 0; ks < 4; ++ks) stf[d][ks] = *(const bf16x8*)(stp + (size_t)(16 * dt + lr) * 128 + 32 * ks + quad * 8);
        gtv[d] = *(const u32x2*)(GHG + (tok0 + 16 * tt + lr) * 1024 + h * 128 + 16 * dt + quad * 4); }
    float tot = 0.f;
#pragma unroll
    for (int i = 0; i < 16; ++i) tot += g[i];
    segtot[seg * 128 + c] = tot;
#pragma unroll
    for (int i = 0; i < 2; ++i) { const int cid = tid + 512 * i, kv = cid >> 4, dvs = (cid & 15) * 8; *(LAS bf16x8*)(Vs + kv * 160 + dvs) = v8[i]; }
    __syncthreads();
    float off = 0.f;
#pragma unroll
    for (int s = 0; s < 4; ++s) { const float t_ = segtot[s * 128 + c]; if (s < seg) off += t_; }
    const float bmid = segtot[c] + segtot[128 + c];
    float run = off;
#pragma unroll
    for (int i = 0; i < 16; ++i) { const int s = 16 * seg + i; run += g[i];
        const float qv = bf2f(qraw[i]); const float kk = 1.f - fexp(g[i]);
        Qt[s * 136 + c] = (bf16)(pk2(qv * fexp(run - bmid), 0.f) & 0xffffu);
        Kt[s * 136 + c] = (bf16)(pk2(kk * fexp(bmid - run), 0.f) & 0xffffu);
        Qh[s * 136 + c] = (bf16)(pk2(qv * fexp(run), 0.f) & 0xffffu); }
    const int nunit = unit + G; const bool has = nunit < 2048;
    if (has) HGO_LOAD(nunit);
    __syncthreads();
#pragma unroll
    for (int e = 0; e < 2; ++e) { const int id = 2 * wave + e, tt = id >> 2, st = id & 3;
        pg8::f32x4 acc = {0.f, 0.f, 0.f, 0.f};
        if (st <= tt) {
#pragma unroll
            for (int ks = 0; ks < 4; ++ks) { const bf16x8 a = *(const LAS bf16x8*)(Kt + (16 * st + lr) * 136 + 32 * ks + quad * 8); const bf16x8 b = *(const LAS bf16x8*)(Qt + (16 * tt + lr) * 136 + 32 * ks + quad * 8);
                acc = __builtin_amdgcn_mfma_f32_16x16x32_bf16(a, b, acc, 0, 0, 0); }
            const int tpos = 16 * tt + lr, s0 = 16 * st + quad * 4;
#pragma unroll
            for (int j = 0; j < 4; ++j) acc[j] = (s0 + j <= tpos) ? acc[j] : 0.f;
        }
        u32x2 w; w.x = pk2(acc[0], acc[1]); w.y = pk2(acc[2], acc[3]); *(LAS u32x2*)(At + (16 * tt + lr) * 72 + 16 * st + quad * 4) = w; }
    __syncthreads();
    pg8::f32x4 acc[4];
    bf16x8 bA[2], bQ[4];
#pragma unroll
    for (int ks = 0; ks < 2; ++ks) bA[ks] = *(const LAS bf16x8*)(At + (16 * tt + lr) * 72 + 32 * ks + quad * 8);
#pragma unroll
    for (int ks = 0; ks < 4; ++ks) bQ[ks] = *(const LAS bf16x8*)(Qh + (16 * tt + lr) * 136 + 32 * ks + quad * 8);
    float ss = 0.f;
#pragma unroll
    for (int d = 0; d < 4; ++d) { const int dt = 4 * dh + d; acc[d] = (pg8::f32x4){0.f, 0.f, 0.f, 0.f};
#pragma unroll
        for (int ks = 0; ks < 2; ++ks) { const LAS bf16* vp = Vs + (32 * ks + quad * 8 + (lr >> 2)) * 160 + 16 * dt + 4 * (lr & 3);
            const s16x4 lo = __builtin_bit_cast(s16x4, __builtin_amdgcn_ds_read_tr16_b64_v4i16((LAS v4i16_t*)vp)), hi = __builtin_bit_cast(s16x4, __builtin_amdgcn_ds_read_tr16_b64_v4i16((LAS v4i16_t*)(vp + 4 * 160)));
            const bf16x8 a = __builtin_shufflevector(lo, hi, 0, 1, 2, 3, 4, 5, 6, 7); acc[d] = __builtin_amdgcn_mfma_f32_16x16x32_bf16(a, bA[ks], acc[d], 0, 0, 0); }
#pragma unroll
        for (int ks = 0; ks < 4; ++ks) acc[d] = __builtin_amdgcn_mfma_f32_16x16x32_bf16(stf[d][ks], bQ[ks], acc[d], 0, 0, 0);
        ss += (acc[d][0] * acc[d][0] + acc[d][1] * acc[d][1]) + (acc[d][2] * acc[d][2] + acc[d][3] * acc[d][3]); }
    ss += shflx(ss, 16); ss += shflx(ss, 32);
    if (quad == 0) ssq[(16 * tt + lr) * 2 + dh] = ss;
    __syncthreads();
    const float r = rsqrtf((ssq[(16 * tt + lr) * 2] + ssq[(16 * tt + lr) * 2 + 1]) * (1.f / 128.f) + EPS);
    const size_t tok = tok0 + 16 * tt + lr;
#pragma unroll
    for (int d = 0; d < 4; ++d) { const int dv0 = 16 * (4 * dh + d) + quad * 4;
        const u32x2 gt = gtv[d]; const f32x4 gn = *(const f32x4*)(og + dv0);
        float gv[4] = {__uint_as_float(gt.x << 16), __uint_as_float(gt.x & 0xffff0000u), __uint_as_float(gt.y << 16), __uint_as_float(gt.y & 0xffff0000u)};
        float o[4];
#pragma unroll
        for (int j = 0; j < 4; ++j) o[j] = acc[d][j] * r * gn[j] * gv[j] * __builtin_amdgcn_rcpf(1.f + fexp(-gv[j]));
        u32x2 w; w.x = pk2(o[0], o[1]); w.y = pk2(o[2], o[3]); *(u32x2*)(MIX + tok * DM + 1024 + h * 128 + dv0) = w; }
    __syncthreads();
    if (!has) break;
    unit = nunit;
    }
#undef HGO_LOAD
}

constexpr int ATT_KP = 136, ATT_VP = 160, ATT_KSLOT = 64 * ATT_KP * 2, ATT_VSLOT = 64 * ATT_VP * 2;
template <bool DIFF, int ND0> DI void att_qk_softmax(const LAS unsigned char* Kc, const bf16x8 (&qf)[ND0], const LAS float* tbl, int t, int qbase, int r, int h_, bool act1,
                                                      float& m_run, float& l_run, f32x16& negm, f32x16 (&y)[4], bf16x8 (&pf)[2][2]) {
    f32x16 p[2];
#pragma unroll
    for (int sub = 0; sub < 2; ++sub) {
        p[sub] = negm;
        if (sub == 0 || act1) {
#pragma unroll
            for (int d0 = 0; d0 < ND0; ++d0) { const bf16x8 kf = *(const LAS bf16x8*)(Kc + (32 * sub * ATT_KP + 16 * d0) * 2);
                p[sub] = __builtin_amdgcn_mfma_f32_32x32x16_bf16(kf, qf[d0], p[sub], 0, 0, 0); }
        }
    }
    const bool far = !DIFF || (qbase - (64 * t + 63) >= 128);
    if (!far) {
        const int qpos = qbase + r;
#pragma unroll
        for (int sub = 0; sub < 2; ++sub)
#pragma unroll
            for (int i = 0; i < 16; ++i) { const int dist = qpos - (64 * t + 32 * sub + crow(i, h_));
                const int idx = dist < 0 ? 0 : (dist > 255 ? 255 : dist); float s = p[sub][i] + tbl[idx]; s = dist >= 0 ? s : -INFINITY;
                if (sub == 1 && !act1) s = -INFINITY;
                p[sub][i] = s; }
    }
    float mx = -INFINITY;
#pragma unroll
    for (int sub = 0; sub < 2; ++sub)
#pragma unroll
        for (int i = 0; i < 16; ++i) mx = fmaxf(mx, p[sub][i]);
    mx = xmax32(mx);
    if (t == 0 || __any(mx > 8.f)) {
        const float dl = (t == 0) ? mx : fmaxf(mx, 0.f), alpha = __builtin_amdgcn_exp2f(-dl);
        m_run += dl; l_run *= alpha;
#pragma unroll
        for (int i = 0; i < 16; ++i) { negm[i] = -m_run; p[0][i] -= dl; p[1][i] -= dl; }
#pragma unroll
        for (int d0 = 0; d0 < 4; ++d0)
#pragma unroll
            for (int i = 0; i < 16; ++i) y[d0][i] *= alpha;
    }
    float rs = 0.f;
#pragma unroll
    for (int sub = 0; sub < 2; ++sub)
#pragma unroll
        for (int i = 0; i < 16; ++i) { const float e = __builtin_amdgcn_exp2f(p[sub][i]); p[sub][i] = e; rs += e; }
    l_run += rs;
#pragma unroll
    for (int sub = 0; sub < 2; ++sub)
#pragma unroll
        for (int s = 0; s < 2; ++s) { u32x4 pw; pw.x = pk2(p[sub][8 * s], p[sub][8 * s + 1]); pw.y = pk2(p[sub][8 * s + 2], p[sub][8 * s + 3]); pw.z = pk2(p[sub][8 * s + 4], p[sub][8 * s + 5]); pw.w = pk2(p[sub][8 * s + 6], p[sub][8 * s + 7]);
            pf[sub][s] = __builtin_bit_cast(bf16x8, pw); }
}
DI void att_pv(const LAS unsigned char* Vc, const bf16x8 (&pf)[2][2], f32x16 (&y)[4], bool act1) {
#pragma unroll
    for (int sub = 0; sub < 2; ++sub) {
        if (sub == 0 || act1) {
#pragma unroll
            for (int s = 0; s < 2; ++s) {
            __builtin_amdgcn_sched_barrier(0);
#pragma unroll
                for (int d0 = 0; d0 < 4; ++d0) { const LAS unsigned char* vp = Vc + ((32 * sub + 16 * s) * ATT_VP + 32 * d0) * 2;
                    const s16x4 lo = __builtin_bit_cast(s16x4, __builtin_amdgcn_ds_read_tr16_b64_v4i16((LAS v4i16_t*)vp));
                    const s16x4 hi = __builtin_bit_cast(s16x4, __builtin_amdgcn_ds_read_tr16_b64_v4i16((LAS v4i16_t*)(vp + 8 * ATT_VP * 2)));
                    const bf16x8 vf = __builtin_shufflevector(lo, hi, 0, 1, 2, 3, 4, 5, 6, 7);
                    y[d0] = __builtin_amdgcn_mfma_f32_32x32x16_bf16(vf, pf[sub][s], y[d0], 0, 0, 0); }
            }
        }
    }
    __builtin_amdgcn_sched_barrier(0);
}
template <bool DIFF> DI void attn_unit(LAS unsigned char* L, const bf16* Qh, int qpitch, const bf16* Kh, const bf16* Vh, int kvpitch, bf16* Oh, int opitch,
                                       size_t qrow0, int qpos0, size_t kvrow0, int NT, const float* relb_h  , float lam, float postscale, const float* subg,
                                       int tid, int wave, int lane) {
    constexpr int ND0 = DIFF ? 4 : 8;
    constexpr int KP = ATT_KP, VP = ATT_VP, KSLOT = ATT_KSLOT, VSLOT = ATT_VSLOT;
    LAS float* tbl = (LAS float*)(L + 2 * KSLOT + 3 * VSLOT);
    LAS float* exch = (LAS float*)L;
    const int r = lane & 31, h_ = lane >> 5, g_ = (lane >> 4) & 1, q_ = (lane & 15) >> 2, p_ = lane & 3;
    const int wq0 = DIFF ? (wave >> 1) * 32 : wave * 32, kcol = DIFF ? (wave & 1) * 64 : 0;
    const bool stag = wave >= 4;
    bf16x8 qf[ND0];
    { const bf16* qp = Qh + (qrow0 + wq0 + r) * (size_t)qpitch + kcol + 8 * h_;
#pragma unroll
      for (int d0 = 0; d0 < ND0; ++d0) qf[d0] = *(const bf16x8*)(qp + 16 * d0); }
    f32x16 y[4];
#pragma unroll
    for (int d0 = 0; d0 < 4; ++d0)
#pragma unroll
        for (int i = 0; i < 16; ++i) y[d0][i] = 0.f;
    float m_run = 0.f, l_run = 0.f;
    f32x16 negm;
#pragma unroll
    for (int i = 0; i < 16; ++i) negm[i] = 0.f;
    bf16x8 kreg[2], vreg[2];
    const int skv0 = tid >> 4, scol = (tid & 15) * 8;
    const int loff = skv0 * kvpitch + scol;
#define ATT_LOAD(t) do { const int tw_ = DIFF ? (t) : ((t) & 3); const bf16* Kt_ = Kh + (kvrow0 + (size_t)tw_ * 64) * kvpitch; const bf16* Vt_ = Vh + (kvrow0 + (size_t)tw_ * 64) * kvpitch; \
        _Pragma("unroll") for (int i_ = 0; i_ < 2; ++i_) { kreg[i_] = *(const bf16x8*)(Kt_ + loff + 32 * i_ * kvpitch); vreg[i_] = *(const bf16x8*)(Vt_ + loff + 32 * i_ * kvpitch); } } while (0)
#define ATT_STORE(ks, vs) do { _Pragma("unroll") for (int i_ = 0; i_ < 2; ++i_) { const int kv_ = skv0 + 32 * i_; \
        *(LAS bf16x8*)(L + (ks) * KSLOT + (kv_ * KP + scol) * 2) = kreg[i_]; *(LAS bf16x8*)(L + 2 * KSLOT + (vs) * VSLOT + (kv_ * VP + scol) * 2) = vreg[i_]; } } while (0)
    ATT_LOAD(0);
    float tb_ = 0.f; if (DIFF && tid < 256) tb_ = relb_h[tid];
    ATT_STORE(0, 0);
    if (NT > 1) ATT_LOAD(1);
    if (DIFF && tid < 256) tbl[tid] = tb_;
    __syncthreads();
    const int koff = ((r * KP) + kcol + 8 * h_) * 2;
    const int voff = 2 * KSLOT + ((4 * h_ + q_) * VP + 16 * g_ + 4 * p_) * 2;
    bf16x8 pf[2][2]; bool pa0 = false, pa1 = false;
#pragma unroll
    for (int a = 0; a < 2; ++a)
#pragma unroll
        for (int b = 0; b < 2; ++b) pf[a][b] = (bf16x8){0, 0, 0, 0, 0, 0, 0, 0};
    int vcur = 0, vprev = 2;
    const int qbase = qpos0 + wq0, qlast = qbase + 31;
    for (int t = 0; t < NT; ++t) {
        const int cur = t & 1, vnext = (vcur == 2) ? 0 : vcur + 1;
        if (t + 1 < NT) ATT_STORE(cur ^ 1, vnext);
        if (t + 2 < NT) ATT_LOAD(t + 2);
        const LAS unsigned char* Kc = L + cur * KSLOT + koff;
        const bool act0 = !DIFF || (64 * t <= qlast), act1 = !DIFF || (64 * t + 32 <= qlast);
        if (stag && pa0) att_pv(L + voff + vprev * VSLOT, pf, y, pa1);
        if (act0) att_qk_softmax<DIFF, ND0>(Kc, qf, tbl, t, qbase, r, h_, act1, m_run, l_run, negm, y, pf);
        if (!stag && act0) att_pv(L + voff + vcur * VSLOT, pf, y, act1);
        pa0 = act0; pa1 = act1;
        vprev = vcur; vcur = vnext;
        __syncthreads();
    }
    if (stag && pa0) att_pv(L + voff + vprev * VSLOT, pf, y, pa1);
    __syncthreads();
#undef ATT_LOAD
#undef ATT_STORE
    const float inv = 1.f / xsum32(l_run);
    int le_ = lane; asm volatile("" : "+v"(le_));
    const int r_e = le_ & 31, h_e = le_ >> 5;
    bf16* orow = Oh + (qrow0 + wq0 + r_e) * (size_t)opitch;
    if (DIFF) {
        const int qs = wave >> 1, mp = wave & 1;
        if (mp == 1) {
#pragma unroll
            for (int d0 = 0; d0 < 4; ++d0)
#pragma unroll
                for (int i = 0; i < 16; ++i) exch[((qs * 4 + d0) * 16 + i) * 64 + le_] = y[d0][i] * inv;
        }
        __syncthreads();
        if (mp == 0) {
            float ss = 0.f;
#pragma unroll
            for (int d0 = 0; d0 < 4; ++d0)
#pragma unroll
                for (int i = 0; i < 16; ++i) { const float o = y[d0][i] * inv - lam * exch[((qs * 4 + d0) * 16 + i) * 64 + le_]; y[d0][i] = o; ss += o * o; }
            ss += shflx(ss, 32);
            const float rr = rsqrtf(ss * (1.f / 128.f) + EPS) * postscale;
#pragma unroll
            for (int d0 = 0; d0 < 4; ++d0)
#pragma unroll
                for (int g = 0; g < 4; ++g) { const int dv0 = 32 * d0 + 8 * g + 4 * h_e; const f32x4 sg = *(const f32x4*)(subg + dv0);
                    u32x2 w; w.x = pk2(y[d0][4 * g] * rr * sg.x, y[d0][4 * g + 1] * rr * sg.y); w.y = pk2(y[d0][4 * g + 2] * rr * sg.z, y[d0][4 * g + 3] * rr * sg.w);
                    *(u32x2*)(orow + dv0) = w; }
        }
    } else {
#pragma unroll
        for (int d0 = 0; d0 < 4; ++d0)
#pragma unroll
            for (int g = 0; g < 4; ++g) { const int dv0 = 32 * d0 + 8 * g + 4 * h_e;
                u32x2 w; w.x = pk2(y[d0][4 * g] * inv, y[d0][4 * g + 1] * inv); w.y = pk2(y[d0][4 * g + 2] * inv, y[d0][4 * g + 3] * inv);
                *(u32x2*)(orow + dv0) = w; }
    }
    __syncthreads();
}

#define XB_TMO      128
#define XB_XCNT(j)  (256  + 64 * (j))
#define XB_XSUB(j)  (1280 + 64 * (j))
#define XB_XGEN(j)  (2304 + 64 * (j))
#define XB_TOP      3328
#define XB_TOPGEN   3392
#define XCD_BAR_WORDS 3456
#define XB_SPIN_CAP (1u << 18)

__device__ __forceinline__ unsigned xb_ld(unsigned* p)              { return __hip_atomic_load(p, __ATOMIC_RELAXED, __HIP_MEMORY_SCOPE_AGENT); }
__device__ __forceinline__ unsigned xb_add(unsigned* p, unsigned v) { return __hip_atomic_fetch_add(p, v, __ATOMIC_RELAXED, __HIP_MEMORY_SCOPE_AGENT); }
__device__ __forceinline__ unsigned xb_xcc_id() { return (unsigned)__builtin_amdgcn_s_getreg((3 << 11) | 20) & 0xFu; }
#define XB_SPIN(cond, bar) do { unsigned _sp = 0; while (cond) { __builtin_amdgcn_s_sleep(1); \
    if ((++_sp & 255u) == 0u) { if (xb_ld(&(bar)[XB_TMO])) break; if (_sp > XB_SPIN_CAP) { atomicAdd(&(bar)[XB_TMO], 1u); break; } } } } while (0)

struct XcdBarrier {
    unsigned* bar; unsigned x;
    volatile LAS unsigned* st;
};

__device__ __forceinline__ XcdBarrier xcd_barrier_post(unsigned* bar, volatile LAS unsigned* st, int xtid) {
    XcdBarrier b; b.bar = bar; b.x = xb_xcc_id(); b.st = st;
    if (xtid == 0) (void)xb_add(&bar[XB_XCNT(b.x)], 1u);
    return b;
}
__device__ __forceinline__ void xcd_barrier_complete(unsigned* bar, unsigned x, unsigned& nloc, unsigned& nx) {
    const unsigned G = gridDim.x * gridDim.y * gridDim.z;
    unsigned sum, cnt, mine, sp = 0u;
    for (;;) {
        sum = 0u; cnt = 0u; mine = 0u;
#pragma unroll
        for (unsigned j = 0; j < 16; ++j) { const unsigned c = xb_ld(&bar[XB_XCNT(j)]); sum += c; cnt += (c > 0u) ? 1u : 0u; mine = (j == x) ? c : mine; }
        if (sum == G) break;
        __builtin_amdgcn_s_sleep(1);
        if ((++sp & 255u) == 0u) { if (xb_ld(&bar[XB_TMO])) break; if (sp > XB_SPIN_CAP) { atomicAdd(&bar[XB_TMO], 1u); break; } }
    }
    nloc = mine > 0u ? mine : 1u; nx = cnt > 0u ? cnt : 1u;
}

__device__ __forceinline__ void xcd_barrier(const XcdBarrier& b, int xtid) {
    asm volatile("s_waitcnt vmcnt(0)" ::: "memory");
    __syncthreads();
    if (xtid == 0) {
        unsigned* bar = b.bar;
        __builtin_amdgcn_s_waitcnt(0);
        unsigned nloc = b.st[0], nx = b.st[1];
        if (nloc == 0u) { xcd_barrier_complete(bar, b.x, nloc, nx); b.st[0] = nloc; b.st[1] = nx; }
        const unsigned old = xb_add(&bar[XB_XSUB(b.x)], 1u);
        const unsigned gen = old / nloc;
        if (old + 1u == (gen + 1u) * nloc) {
            __builtin_amdgcn_fence(__ATOMIC_RELEASE, "agent");
            asm volatile("s_waitcnt vmcnt(0)" ::: "memory");
            const unsigned og = xb_add(&bar[XB_TOP], 1u);
            const unsigned tg = og / nx;
            if (og + 1u == (tg + 1u) * nx) xb_add(&bar[XB_TOPGEN], 1u);
            else XB_SPIN(xb_ld(&bar[XB_TOPGEN]) == tg, bar);
            __builtin_amdgcn_fence(__ATOMIC_ACQUIRE, "agent");
            xb_add(&bar[XB_XGEN(b.x)], 1u);
            asm volatile("s_waitcnt vmcnt(0)" ::: "memory");
        } else {
            XB_SPIN(xb_ld(&bar[XB_XGEN(b.x)]) == gen, bar);
            __builtin_amdgcn_fence(__ATOMIC_ACQUIRE, "agent");
            asm volatile("s_waitcnt vmcnt(0)" ::: "memory");
        }
    }
    __syncthreads();
}

struct Params { const float* in[24]; float* out; unsigned char* ws; };


template <class Epi> DI void run_gemm(LAS unsigned char* L, int tid, const bf16* A, const bf16* Bt, int M, int N, int K, const Epi& E, int shift = 0) {
    pg8::Gemm g{A, Bt, M, N, K}; pg8::StaticOrder S; S.init(M, N, (int)gridDim.x, (int)((blockIdx.x + shift) % gridDim.x));
    pg8::gemm_phase<Epi, pg8::StaticOrder, true, true>(L, g, S, E, tid);
}

__global__ void __launch_bounds__(512, 2) mega_fwd(Params P) {
    extern __shared__ __attribute__((aligned(16))) unsigned char lds_raw[];
    LAS unsigned char* L = (LAS unsigned char*)lds_raw;
    cg::grid_group grid = cg::this_grid();
    const int G = gridDim.x, bid = blockIdx.x, NGW = G * 8, NTH = G * 512;
    const int wave0 = __builtin_amdgcn_readfirstlane((int)(threadIdx.x >> 6));
#define TIDX() (wave0 * 64 + lane_id_opaque())
#define PH_BEGIN() int tid = wave0 * 64 + lane_id_opaque(); long zoff_ = 0; asm volatile("" : "+v"(tid), "+s"(zoff_)); unsigned char* ws = P.ws + zoff_; \
    const int lane = tid & 63, wave = __builtin_amdgcn_readfirstlane(tid >> 6), gw = bid * 8 + wave, gtid = bid * 512 + tid; unsigned char* rd = ws + WS_RD; \
    (void)lane; (void)wave; (void)gw; (void)gtid; (void)rd;
#define X (P.out)
    volatile LAS unsigned* MISC = (volatile LAS unsigned*)(L + LDS_MISC);
    { const int t0 = TIDX(); if (t0 < 2) MISC[t0] = 0u;
      unsigned* barw = (unsigned*)(P.ws + WS_BAR);
      if (bid == 0) for (int i = t0; i < XCD_BAR_WORDS; i += 512) barw[i] = 0u; }
    __syncthreads();
#define GRID_SYNC() do { asm volatile("s_waitcnt vmcnt(0) lgkmcnt(0)" ::: "memory"); grid.sync(); } while (0)
#define XSYNC() do { XcdBarrier xb_; xb_.bar = (unsigned*)(P.ws + WS_BAR); xb_.x = xb_xcc_id(); xb_.st = (volatile LAS unsigned*)(L + LDS_MISC); xcd_barrier(xb_, TIDX()); } while (0)

    { PH_BEGIN();
      convert_weights(P.in, 0, ws, L, gw, NGW, wave, lane);
      float* LB = (float*)(ws + WS_LB);
      { float* TBL = (float*)(ws + WS_TBL);
        for (int i = gtid; i < 2048; i += NTH) { const int hh = i >> 8, nn = i & 255; int bk;
            if (nn < 16) bk = nn; else { bk = 16 + (int)(__logf((float)nn * (1.f / 16.f)) / 2.0794415416798357f * 16.f); bk = bk > 31 ? 31 : bk; }
            TBL[i] = (P.in[23][bk * 8 + hh] - P.in[23][31 * 8 + hh]) * LOG2E; } }
      for (int i = gtid; i < 2048; i += NTH) { const int c = i & 1023; LB[i] = (i < 1024) ? 0.f : 1.f / (1.f + fexp(P.in[22][c] - P.in[22][1024 + c])); }
      norm_rows(P.in[0], T, P.in[9], (bf16*)(ws + WS_H), gw, NGW, lane); }
    GRID_SYNC();
    (void)xcd_barrier_post((unsigned*)(P.ws + WS_BAR), (volatile LAS unsigned*)(L + LDS_MISC), TIDX());

    for (int l = 0; l < 2; ++l) {
        { PH_BEGIN(); EpiInProj E{rd, (const float*)(ws + WS_LB) + l * 1024}; run_gemm(L, tid, (const bf16*)(ws + WS_H), (const bf16*)(ws + WS_WIN), T, INC, DM, E); }
        XSYNC();
        { PH_BEGIN();
          hg_state_units(L, bid, G, (const float*)(rd + RD_LOGF), (const bf16*)(rd + RD_IHG), (bf16*)(ws + WS_H), (float*)(ws + WS_DEC), tid, wave, lane); }
        { PH_BEGIN();
            const float lam_init = (l == 0) ? 0.2f : (0.8f - 0.6f * 0.7408182206817179f);
            const float a1 = wave_sum(P.in[18][l * 64 + lane] * P.in[19][l * 64 + lane]), a2 = wave_sum(P.in[20][l * 64 + lane] * P.in[21][l * 64 + lane]);
            const float lam = __uint_as_float(__builtin_amdgcn_readfirstlane(__float_as_uint(fexp(a1) - fexp(a2) + lam_init)));
            const int vcu = (G == 256) ? (((bid & 7) << 5) | (bid >> 3)) : bid;
            for (int sidx = vcu; sidx < 1024; sidx += G) {
                const int i = sidx >> 8, v = sidx & 255, bh = v >> 3, s = v & 7, b_ = bh >> 3, h = bh & 7;
                const int qb = (i == 0) ? s : (i == 1) ? 15 - s : (i == 2) ? 16 + s : 31 - s;
                attn_unit<true>(L, (const bf16*)(rd + RD_QDA) + h * 128, 1024, (const bf16*)(rd + RD_KDA) + h * 128, (const bf16*)(rd + RD_VDA) + h * 128, 1024, (bf16*)(rd + RD_MIX) + h * 128, DM,
                                (size_t)b_ * SEQ + qb * 128, qb * 128, (size_t)b_ * SEQ, 2 * qb + 2, (const float*)(ws + WS_TBL) + h * 256, lam, 1.f - lam_init, P.in[16] + l * 128, tid, wave, lane);
            }
        }
        XSYNC();
        { PH_BEGIN(); hg_scan((bf16*)(ws + WS_H), (const float*)(ws + WS_DEC), gtid, NTH); }
        XSYNC();
        { PH_BEGIN();
          hg_out_units(L, bid, G, (const float*)(rd + RD_LOGF), (const bf16*)(rd + RD_QHG), (const bf16*)(rd + RD_IHG), (const bf16*)(rd + RD_GHG), (const bf16*)(ws + WS_H), P.in[17] + l * 128, (bf16*)(rd + RD_MIX), tid, wave, lane); }
        XSYNC();
        { PH_BEGIN(); EpiF32 E{(float*)(rd + RD_Y), DM}; run_gemm(L, tid, (const bf16*)(rd + RD_MIX), (const bf16*)(ws + WS_WOUT), T, DM, DM, E); }
        XSYNC();
        { PH_BEGIN();
          resnorm_rows((const float*)(rd + RD_Y), l == 0 ? P.in[0] : X, X, P.in[10] + l * DM, P.in[11] + l * DM, (bf16*)(ws + WS_H), gw, NGW, lane);
          norm_rows(P.in[1], MEMT, P.in[13] + l * DM, (bf16*)(rd + RD_MN), gw, NGW, lane); }
        XSYNC();
        { PH_BEGIN(); EpiB16 E{(bf16*)(rd + RD_QX), CXW, 0.08838834764831845f * LOG2E}; run_gemm(L, tid, (const bf16*)(ws + WS_H), (const bf16*)(ws + WS_WCQ), T, CXW, DM, E); }
        { PH_BEGIN(); EpiB16 E{(bf16*)(rd + RD_KV), 1024, 1.f}; run_gemm(L, tid, (const bf16*)(rd + RD_MN), (const bf16*)(ws + WS_WCKV), MEMT, 1024, DM, E, G / 2); }
        XSYNC();
        { PH_BEGIN();
          for (int u = (G == 256) ? (((bid & 7) << 5) | (bid >> 3)) : bid; u < 256; u += G) { const int b_ = u >> 6, h = (u >> 4) & 3, qb = u & 15; const bf16* KV = (const bf16*)(rd + RD_KV);
            attn_unit<false>(L, (const bf16*)(rd + RD_QX) + h * 128, CXW, KV + h * 128, KV + 512 + h * 128, 1024, (bf16*)(rd + RD_OX) + h * 128, CXW,
                             (size_t)b_ * SEQ + qb * 256, 0, (size_t)b_ * 256, 4, nullptr, 0.f, 1.f, nullptr, tid, wave, lane); } }
        XSYNC();
        { PH_BEGIN(); EpiF32 E{(float*)(rd + RD_Y), DM}; run_gemm(L, tid, (const bf16*)(rd + RD_OX), (const bf16*)(ws + WS_WCO), T, DM, CXW, E); }
        XSYNC();
        { PH_BEGIN(); resnorm_rows((const float*)(rd + RD_Y), X, X, P.in[12] + l * DM, P.in[14] + l * DM, (bf16*)(ws + WS_H), gw, NGW, lane); }
        XSYNC();
        { PH_BEGIN(); EpiSwiGLU E{(bf16*)(rd + RD_HID), FH}; run_gemm(L, tid, (const bf16*)(ws + WS_H), (const bf16*)(ws + WS_WFI), T, 2 * FH, DM, E); }
        XSYNC();
        { PH_BEGIN(); EpiF32 E{(float*)(rd + RD_Y), DM}; run_gemm(L, tid, (const bf16*)(rd + RD_HID), (const bf16*)(ws + WS_WFO), T, DM, FH, E); }
        XSYNC();
        if (l == 0) {
            { PH_BEGIN(); resnorm_rows((const float*)(rd + RD_Y), X, X, P.in[15] + l * DM, P.in[9] + DM, (bf16*)(ws + WS_H), gw, NGW, lane); }
            { PH_BEGIN(); convert_weights(P.in, 1, ws, L, gw, NGW, wave, lane); }
            XSYNC();
        } else {
            { PH_BEGIN(); resnorm_rows((const float*)(rd + RD_Y), X, X, P.in[15] + l * DM, nullptr, nullptr, gw, NGW, lane); }
        }
    }
}

extern "C" void kernel_launch(void* const* d_in, const int* in_sizes, int n_in, void* d_out, int out_size, void* d_ws, size_t ws_size, hipStream_t stream) {
    static int grid = 0;
    if (grid == 0) {
        if (n_in != 24 || out_size != T * DM || ws_size < WS_END) { fprintf(stderr, "kernel_launch: unexpected problem (n_in %d out %d ws %zu)\n", n_in, out_size, ws_size); grid = -1; return; }
        int dev = 0, cus = 0, per_cu = 0;
        hipGetDevice(&dev); hipDeviceGetAttribute(&cus, hipDeviceAttributeMultiprocessorCount, dev);
        hipFuncSetAttribute((const void*)mega_fwd, hipFuncAttributeMaxDynamicSharedMemorySize, LDS_BYTES);
        hipOccupancyMaxActiveBlocksPerMultiprocessor(&per_cu, (const void*)mega_fwd, 512, LDS_BYTES);
        if (per_cu < 1) { fprintf(stderr, "kernel_launch: occupancy query says %d blocks per CU\n", per_cu); per_cu = 1; }
        (void)hipGetLastError();
        grid = cus;
    }
    if (grid < 0) return;
    Params p{};
    for (int i = 0; i < 24; ++i) p.in[i] = (const float*)d_in[i];
    p.out = (float*)d_out; p.ws = (unsigned char*)d_ws;
    void* args[] = {&p};
    hipError_t e = hipLaunchCooperativeKernel((const void*)mega_fwd, dim3(grid), dim3(512), args, LDS_BYTES, stream);
    if (e != hipSuccess) fprintf(stderr, "cooperative launch failed: %s (grid %d)\n", hipGetErrorString(e), grid);
}
```
